# Optimizing an MI355X kernel written in HIP

```python
import math, functools
import jax, jax.numpy as jnp
from jax import lax
import numpy as np

D_MODEL = 1024
BATCH = 4
SEQ = 4096
DEPTH = 4

GRID_W = 64
CTX_LEN = 256
EPS = 1e-6

HY_W = 256
HY_ORDER = 2
HY_BANDS = 8
HY_EMB = 1 + 2 * HY_BANDS
HY_FF = 64
HY_DECAY_MIN = 3.0
HY_DECAY_MAX = 15.0
S5_W = 256
S5_CH = 16
S5_GROUPS = S5_W // S5_CH
S5_N = 64
ML_HEADS = 4
ML_HD = 128
ML_W = ML_HEADS * ML_HD
ML_CHUNK = 64
ML_GATES = 4 * ML_HEADS
SHORT_K = 3
MIX_W = HY_W + S5_W + ML_W
MLP_W = 4 * D_MODEL
PROJ_W = 3 * HY_W + S5_W + 3 * ML_W + ML_GATES
PROJ_SPLITS = (3 * HY_W,
               3 * HY_W + S5_W,
               3 * HY_W + S5_W + ML_W,
               3 * HY_W + S5_W + 2 * ML_W,
               3 * HY_W + S5_W + 3 * ML_W)

kernel_name = 'hybrid_hyena_s5_mlstm_dit'


def rms_norm(x, gain):
    xf = x.astype(jnp.float32)
    y = xf * lax.rsqrt(jnp.mean(xf * xf, axis=-1, keepdims=True) + EPS)
    return (y * gain.astype(jnp.float32)).astype(x.dtype)


def depthwise_conv1d(u, w):
    return lax.conv_general_dilated(
        u, w[:, None, :].astype(u.dtype), window_strides=(1,), padding='SAME',
        dimension_numbers=('NWC', 'WIO', 'NWC'), feature_group_count=u.shape[-1])


def depthwise_conv2d_grid(u, w, rows):
    bsz, length, ch = u.shape
    img = u.reshape(bsz, rows, GRID_W, ch)
    out = lax.conv_general_dilated(
        img, w[:, :, None, :].astype(u.dtype), window_strides=(1, 1), padding='SAME',
        dimension_numbers=('NHWC', 'HWIO', 'NHWC'), feature_group_count=ch)
    return out.reshape(bsz, length, ch)


def hyena_filters(length, w1, b1, w2, b2, w3, freq, decay):
    f32 = jnp.float32
    t = jnp.arange(length, dtype=f32) / length
    bands = jnp.arange(1, HY_BANDS + 1, dtype=f32)
    ang = 2.0 * math.pi * t[:, None] * bands
    feat = jnp.concatenate([t[:, None], jnp.cos(ang), jnp.sin(ang)], axis=-1)
    fr = freq.astype(f32)
    hdn = jnp.sin(fr * (feat @ w1.astype(f32) + b1.astype(f32)))
    hdn = jnp.sin(fr * (hdn @ w2.astype(f32) + b2.astype(f32)))
    filt = (hdn @ w3.astype(f32)).reshape(length, HY_ORDER, 2, HY_W)
    filt = filt * jnp.exp(-t[:, None, None, None] * decay.astype(f32))
    return filt * lax.rsqrt(jnp.sum(filt * filt, axis=(0, 2), keepdims=True) + EPS)


def long_conv(u, h_fwd, h_bwd):
    length = u.shape[1]
    taps = jnp.concatenate([h_fwd, jnp.zeros_like(h_fwd[:1]), h_bwd[:0:-1]], axis=0)
    spec = jnp.fft.rfft(u, n=2 * length, axis=1) * jnp.fft.rfft(taps, axis=0)[None]
    return jnp.fft.irfft(spec, n=2 * length, axis=1)[:, :length]


def hyena_mix(p_hy, conv_w, filt, bias):
    u = depthwise_conv1d(p_hy, conv_w).astype(jnp.float32)
    z, x1, x2 = jnp.split(u, 3, axis=-1)
    for n, gate in enumerate((x1, x2)):
        z = gate * (long_conv(z, filt[:, n, 0], filt[:, n, 1]) + bias[n].astype(jnp.float32) * z)
    return z


def s5_discretise(a_re, a_im, log_dt, b_re, b_im, c_re, c_im):
    f32 = jnp.float32
    lam = lax.complex(a_re.astype(f32), a_im.astype(f32))
    a_bar = jnp.exp(lam * jnp.exp(log_dt.astype(f32))[:, None])
    b_bar = ((a_bar - 1.0) / lam)[..., None] * lax.complex(b_re.astype(f32), b_im.astype(f32))
    c_mat = lax.complex(c_re.astype(f32), c_im.astype(f32))
    return a_bar, b_bar, c_mat


def _linear_combine(e1, e2):
    a1, b1 = e1
    a2, b2 = e2
    return a1 * a2, a2 * b1 + b2


def s5_scan(u, a_bar, b_bar, c_mat, h0):
    bu = jnp.einsum('gnc,blgc->blgn', b_bar, u)
    bu = bu.at[:, 0].add(a_bar * h0)
    a = jnp.broadcast_to(a_bar, bu.shape)
    _, states = lax.associative_scan(_linear_combine, (a, bu), axis=1)
    y = jnp.einsum('gcn,blgn->blgc', c_mat, states).real
    return y, states[:, -1]


def s5_mix(p_s5, disc, d_skip, w_glu, b_glu, h0):
    bsz, length, _ = p_s5.shape
    u = p_s5.astype(jnp.float32)
    uc = u.reshape(bsz, length, S5_GROUPS, S5_CH).astype(jnp.complex64)
    y_f, h_f = s5_scan(uc, *disc[0], h0[0])
    y_b, h_b = s5_scan(uc[:, ::-1], *disc[1], h0[1])
    y = (y_f + y_b[:, ::-1]).reshape(bsz, length, S5_W) + d_skip.astype(jnp.float32) * u
    g = jax.nn.gelu(y)
    return g * jax.nn.sigmoid(g @ w_glu.astype(jnp.float32) + b_glu.astype(jnp.float32)), (h_f, h_b)


def mlstm_chunkwise(q, k, v, log_i, log_f, state):
    bsz, nh, length, dh = q.shape
    nc = length // ML_CHUNK
    q, k, v = (t.reshape(bsz, nh, nc, ML_CHUNK, dh) for t in (q, k, v))
    log_i = log_i.reshape(bsz, nh, nc, ML_CHUNK)
    b = jnp.cumsum(log_f.reshape(bsz, nh, nc, ML_CHUNK), axis=-1)
    g = b[..., -1]
    a = g[..., None] - b + log_i
    m_loc = a.max(axis=-1)
    w = jnp.exp(a - m_loc[..., None])
    c_loc = jnp.einsum('bhcsd,bhcse->bhcde', v * w[..., None], k)
    n_loc = jnp.einsum('bhcs,bhcse->bhce', w, k)

    def step(carry, inp):
        c_st, n_st, m_st = carry
        g_j, m_j, c_j, n_j = inp
        m_new = jnp.maximum(g_j + m_st, m_j)
        dec = jnp.exp(g_j + m_st - m_new)
        grow = jnp.exp(m_j - m_new)
        c_new = dec[..., None, None] * c_st + grow[..., None, None] * c_j
        n_new = dec[..., None] * n_st + grow[..., None] * n_j
        return (c_new, n_new, m_new), (c_st, n_st, m_st)

    front = lambda t: jnp.moveaxis(t, 2, 0)
    final, prev = lax.scan(step, state, (front(g), front(m_loc), front(c_loc), front(n_loc)))
    c_prev, n_prev, m_prev = (jnp.moveaxis(t, 0, 2) for t in prev)

    lower = jnp.tril(jnp.ones((ML_CHUNK, ML_CHUNK), dtype=bool))
    dmat = jnp.where(lower, b[..., :, None] - b[..., None, :] + log_i[..., None, :], -jnp.inf)
    inter = b + m_prev[..., None]
    m_t = jnp.maximum(dmat.max(axis=-1), inter)
    s = jnp.einsum('bhctd,bhcsd->bhcts', q, k) * jnp.exp(dmat - m_t[..., None])
    w_inter = jnp.exp(inter - m_t)
    num = (jnp.einsum('bhcts,bhcsd->bhctd', s, v)
           + w_inter[..., None] * jnp.einsum('bhcde,bhcte->bhctd', c_prev, q))
    nq = s.sum(axis=-1) + w_inter * jnp.einsum('bhce,bhcte->bhct', n_prev, q)
    h = num / jnp.maximum(jnp.abs(nq), jnp.exp(-m_t))[..., None]
    return h.reshape(bsz, nh, length, dh), final


def mlstm_mix(p_x, p_v, p_o, p_g, conv_fn, wq, wk, gate_bias, skip, norm_gain, state):
    f32 = jnp.float32
    bsz, length, _ = p_x.shape
    xc = jax.nn.silu(conv_fn(p_x)).astype(f32)
    xh = xc.reshape(bsz, length, ML_HEADS, ML_HD)
    q = jnp.einsum('blhd,hde->bhle', xh, wq.astype(f32))
    k = jnp.einsum('blhd,hde->bhle', xh, wk.astype(f32)) * (ML_HD ** -0.5)
    v = p_v.astype(f32).reshape(bsz, length, ML_HEADS, ML_HD).transpose(0, 2, 1, 3)
    gates = (p_g.astype(f32).reshape(bsz, length, 4, ML_HEADS)
             + gate_bias.astype(f32)).transpose(2, 0, 3, 1)
    h_f, st_f = mlstm_chunkwise(q, k, v, gates[0], jax.nn.log_sigmoid(gates[1]), state[0])
    rev = lambda t: jnp.flip(t, axis=2)
    h_b, st_b = mlstm_chunkwise(rev(q), rev(k), rev(v), rev(gates[2]),
                                rev(jax.nn.log_sigmoid(gates[3])), state[1])
    h = (h_f + rev(h_b)).transpose(0, 2, 1, 3)
    h = h * lax.rsqrt(jnp.mean(h * h, axis=-1, keepdims=True) + EPS) * norm_gain.astype(f32).reshape(ML_HEADS, ML_HD)
    out = jax.nn.sigmoid(p_o.astype(f32)) * (h.reshape(bsz, length, ML_W) + skip.astype(f32) * xc)
    return out, (st_f, st_b)


def mix_sequence(p, conv_ml, filt, s5_h0, ml_state, hy_conv, hy_bias, s5_disc, s5_d, s5_w_glu,
                 s5_b_glu, ml_wq, ml_wk, ml_gate_bias, ml_skip, ml_norm_gain):
    p_hy, p_s5, p_mx, p_mv, p_mo, p_mg = jnp.split(p, PROJ_SPLITS, axis=-1)
    y_hy = hyena_mix(p_hy, hy_conv, filt, hy_bias)
    y_s5, s5_state = s5_mix(p_s5, s5_disc, s5_d, s5_w_glu, s5_b_glu, s5_h0)
    y_ml, ml_out_state = mlstm_mix(p_mx, p_mv, p_mo, p_mg, conv_ml, ml_wq, ml_wk, ml_gate_bias,
                                   ml_skip, ml_norm_gain, ml_state)
    y = jnp.concatenate([y_hy, y_s5, y_ml], axis=-1).astype(p.dtype)
    return y, s5_state, ml_out_state


def squared_relu_mlp(h, w1, w2):
    return jnp.square(jax.nn.relu(h @ w1)) @ w2


def setup_inputs(seed: int = 0) -> dict:
    key = jax.random.key(seed)
    keys = iter(jax.random.split(key, 64))

    def normal(shape, scale):
        return jax.random.normal(next(keys), shape, jnp.float32) * scale

    def near_one(shape):
        return 1.0 + normal(shape, 0.02)

    d = D_MODEL
    sd = (DEPTH, 2)
    f_bias = jnp.linspace(3.0, 6.0, ML_HEADS, dtype=jnp.float32)
    ml_gate_bias = jnp.stack([normal((DEPTH, ML_HEADS), 0.1),
                              f_bias + normal((DEPTH, ML_HEADS), 0.1),
                              normal((DEPTH, ML_HEADS), 0.1),
                              f_bias + normal((DEPTH, ML_HEADS), 0.1)], axis=1)
    decay = jnp.linspace(HY_DECAY_MIN, HY_DECAY_MAX, HY_W, dtype=jnp.float32)
    state_idx = jnp.arange(S5_N, dtype=jnp.float32)
    return {
        'x': normal((BATCH, SEQ, d), 1.0),
        'c': normal((BATCH, d), 1.0),
        'ctx': normal((BATCH, CTX_LEN, d), 1.0),
        'c_ctx': normal((d,), 1.0),
        'w_mod': normal((DEPTH, d, 6 * d), 0.5 * d ** -0.5),
        'b_mod': normal((DEPTH, 6 * d), 0.02),
        'g_pre_mix': near_one((DEPTH, d)),
        'g_post_mix': near_one((DEPTH, d)),
        'g_pre_mlp': near_one((DEPTH, d)),
        'g_post_mlp': near_one((DEPTH, d)),
        'w_in': normal((DEPTH, d, PROJ_W), d ** -0.5),
        'w_out': normal((DEPTH, MIX_W, d), MIX_W ** -0.5),
        'hy_conv': normal((DEPTH, SHORT_K, 3 * HY_W), SHORT_K ** -0.5),
        'hy_w1': normal((DEPTH, HY_EMB, HY_FF), HY_EMB ** -0.5),
        'hy_b1': normal((DEPTH, HY_FF), 0.1),
        'hy_w2': normal((DEPTH, HY_FF, HY_FF), HY_FF ** -0.5),
        'hy_b2': normal((DEPTH, HY_FF), 0.1),
        'hy_w3': normal((DEPTH, HY_FF, HY_ORDER * 2 * HY_W), HY_FF ** -0.5),
        'hy_freq': 1.0 + normal((DEPTH, HY_FF), 0.1),
        'hy_decay': decay + normal((DEPTH, HY_ORDER, 2, HY_W), 0.1),
        'hy_bias': normal((DEPTH, HY_ORDER, HY_W), 0.1),
        's5_a_re': -0.5 * jnp.exp(normal(sd + (S5_GROUPS, S5_N), 0.05)),
        's5_a_im': math.pi * state_idx + normal(sd + (S5_GROUPS, S5_N), 0.05),
        's5_log_dt': jax.random.uniform(next(keys), sd + (S5_GROUPS,), jnp.float32,
                                        math.log(1e-3), math.log(1e-1)),
        's5_b_re': normal(sd + (S5_GROUPS, S5_N, S5_CH), (2 * S5_CH) ** -0.5),
        's5_b_im': normal(sd + (S5_GROUPS, S5_N, S5_CH), (2 * S5_CH) ** -0.5),
        's5_c_re': normal(sd + (S5_GROUPS, S5_CH, S5_N), S5_N ** -0.5),
        's5_c_im': normal(sd + (S5_GROUPS, S5_CH, S5_N), S5_N ** -0.5),
        's5_d': normal((DEPTH, S5_W), 0.5),
        's5_w_glu': normal((DEPTH, S5_W, S5_W), S5_W ** -0.5),
        's5_b_glu': normal((DEPTH, S5_W), 0.02),
        'ml_conv': normal((DEPTH, SHORT_K, SHORT_K, ML_W), 1.0 / SHORT_K),
        'ml_wq': normal((DEPTH, ML_HEADS, ML_HD, ML_HD), ML_HD ** -0.5),
        'ml_wk': normal((DEPTH, ML_HEADS, ML_HD, ML_HD), ML_HD ** -0.5),
        'ml_gate_bias': ml_gate_bias,
        'ml_skip': near_one((DEPTH, ML_W)),
        'ml_norm_gain': near_one((DEPTH, ML_W)),
        'w_mlp1': normal((DEPTH, d, MLP_W), d ** -0.5),
        'w_mlp2': normal((DEPTH, MLP_W, d), MLP_W ** -0.5),
    }


def reference(x, c, ctx, c_ctx, w_mod, b_mod, g_pre_mix, g_post_mix, g_pre_mlp, g_post_mlp,
              w_in, w_out, hy_conv, hy_w1, hy_b1, hy_w2, hy_b2, hy_w3, hy_freq, hy_decay, hy_bias,
              s5_a_re, s5_a_im, s5_log_dt, s5_b_re, s5_b_im, s5_c_re, s5_c_im, s5_d, s5_w_glu,
              s5_b_glu, ml_conv, ml_wq, ml_wk, ml_gate_bias, ml_skip, ml_norm_gain, w_mlp1, w_mlp2):
    bsz, seq_len, _ = x.shape
    ctx_len = ctx.shape[1]
    rows = seq_len // GRID_W
    s5_zero = jnp.zeros((bsz, S5_GROUPS, S5_N), jnp.complex64)
    ml_zero = (jnp.zeros((bsz, ML_HEADS, ML_HD, ML_HD), jnp.float32),
               jnp.zeros((bsz, ML_HEADS, ML_HD), jnp.float32),
               jnp.zeros((bsz, ML_HEADS), jnp.float32))
    for l in range(DEPTH):
        mod_x = jnp.split(jax.nn.silu(c) @ w_mod[l] + b_mod[l], 6, axis=-1)
        sh1, sc1, gt1, sh2, sc2, gt2 = (m[:, None, :] for m in mod_x)
        csh1, csc1, cgt1, csh2, csc2, cgt2 = jnp.split(jax.nn.silu(c_ctx) @ w_mod[l] + b_mod[l], 6, axis=-1)

        filter_args = (hy_w1[l], hy_b1[l], hy_w2[l], hy_b2[l], hy_w3[l], hy_freq[l], hy_decay[l])
        s5_disc = tuple(s5_discretise(s5_a_re[l, dr], s5_a_im[l, dr], s5_log_dt[l, dr], s5_b_re[l, dr],
                                      s5_b_im[l, dr], s5_c_re[l, dr], s5_c_im[l, dr]) for dr in range(2))
        mix = functools.partial(mix_sequence, hy_conv=hy_conv[l], hy_bias=hy_bias[l], s5_disc=s5_disc,
                                s5_d=s5_d[l], s5_w_glu=s5_w_glu[l], s5_b_glu=s5_b_glu[l],
                                ml_wq=ml_wq[l], ml_wk=ml_wk[l], ml_gate_bias=ml_gate_bias[l],
                                ml_skip=ml_skip[l], ml_norm_gain=ml_norm_gain[l])

        hc = rms_norm(ctx, g_pre_mix[l]) * (1.0 + csc1) + csh1
        y_c, s5_state, ml_state = mix(
            hc @ w_in[l], conv_ml=functools.partial(depthwise_conv1d, w=ml_conv[l, 1]),
            filt=hyena_filters(ctx_len, *filter_args), s5_h0=(s5_zero, s5_zero),
            ml_state=(ml_zero, ml_zero))

        hx = rms_norm(x, g_pre_mix[l]) * (1.0 + sc1) + sh1
        y_x, _, _ = mix(
            hx @ w_in[l], conv_ml=functools.partial(depthwise_conv2d_grid, w=ml_conv[l], rows=rows),
            filt=hyena_filters(seq_len, *filter_args), s5_h0=s5_state, ml_state=ml_state)
        x = x + gt1 * rms_norm(y_x @ w_out[l], g_post_mix[l])
        hx = rms_norm(x, g_pre_mlp[l]) * (1.0 + sc2) + sh2
        x = x + gt2 * rms_norm(squared_relu_mlp(hx, w_mlp1[l], w_mlp2[l]), g_post_mlp[l])

        if l < DEPTH - 1:
            ctx = ctx + cgt1 * rms_norm(y_c @ w_out[l], g_post_mix[l])
            hc = rms_norm(ctx, g_pre_mlp[l]) * (1.0 + csc2) + csh2
            ctx = ctx + cgt2 * rms_norm(squared_relu_mlp(hc, w_mlp1[l], w_mlp2[l]), g_post_mlp[l])
    return x
```

```cpp
#include <hip/hip_runtime.h>
#include <hip/hip_cooperative_groups.h>
#include <cstdio>
namespace cg = cooperative_groups;

#define LAS __attribute__((address_space(3)))
typedef unsigned short bf16_t;
typedef short bf16x8 __attribute__((ext_vector_type(8)));
typedef float f32x4 __attribute__((ext_vector_type(4)));
typedef float f32x16 __attribute__((ext_vector_type(16)));
typedef unsigned u32x4 __attribute__((ext_vector_type(4)));
typedef unsigned u32x2 __attribute__((ext_vector_type(2)));
typedef float f32x2 __attribute__((ext_vector_type(2)));

constexpr int DM = 1024, NB = 4, SEQL = 4096, CTXL = 256, DEPTH = 4;
constexpr int MT = 17408, MLAT = 16384;
constexpr int PW = 2560, PWF = 2576, PWP = 2816;
constexpr float EPS = 1e-6f;
constexpr int NTHR = 512;
constexpr int LDS_BYTES = 143360;

__device__ __forceinline__ int ltid() { int t = threadIdx.x; asm volatile("" : "+v"(t)); return t; }
__device__ __forceinline__ float bf2f(bf16_t b) { return __uint_as_float(((unsigned)b) << 16); }
typedef __bf16 bf16x2_t __attribute__((ext_vector_type(2)));
__device__ __forceinline__ unsigned cvt_pk_bf16(float lo, float hi) { const f32x2 v = {lo, hi}; const bf16x2_t b = __builtin_convertvector(v, bf16x2_t); return __builtin_bit_cast(unsigned, b); }
__device__ __forceinline__ bf16_t f2bf(float f) { return (bf16_t)(cvt_pk_bf16(f, 0.f) & 0xffffu); }
__device__ __forceinline__ float wave_sum(float v) {
#pragma unroll
  for (int o = 32; o; o >>= 1) v += __shfl_xor(v, o);
  return v;
}
__device__ __forceinline__ float sigmoidf_(float x) { return 1.f / (1.f + __expf(-x)); }
__device__ __forceinline__ void lds_wait() { asm volatile("s_waitcnt lgkmcnt(0)" ::: "memory"); }

constexpr size_t al256(size_t x) { return (x + 255) & ~(size_t)255; }
constexpr size_t O_HSUM = 0;
constexpr size_t O_MOD = al256(O_HSUM + 4 * 2 * 2 * 256 * 4);
constexpr size_t O_ZEND = al256(O_MOD + 4 * 5 * 6144 * 4);
constexpr size_t O_S5AB = O_ZEND;
constexpr size_t O_BBT = al256(O_S5AB + 2 * 16 * 64 * 4 * 4);
constexpr size_t O_CMT = al256(O_BBT + 2 * 16 * 128 * 16 * 2);
constexpr size_t O_WQT = al256(O_CMT + 2 * 16 * 16 * 128 * 2);
constexpr size_t O_WKT = al256(O_WQT + 4 * 128 * 128 * 2);
constexpr size_t O_WGLUT = al256(O_WKT + 4 * 128 * 128 * 2);
constexpr size_t O_SC = al256(O_WGLUT + 256 * 256 * 2);
constexpr size_t O_HPART = al256(O_SC + 147456);
constexpr size_t SM_STRIDE = al256(O_HPART + (size_t)2 * 256 * 1024 * 4) - O_S5AB;
#define SM(l) ((size_t)(l) * SM_STRIDE)
constexpr size_t O_HFLAT = O_S5AB + 4 * SM_STRIDE;
constexpr size_t O_HFCTX = al256(O_HFLAT + (size_t)1024 * 4096 * 2);
constexpr size_t O_WINT = al256(O_HFCTX + (size_t)1024 * 256 * 2);
constexpr size_t O_WOUTT = al256(O_WINT + (size_t)PWP * 1024 * 2);
constexpr size_t O_W1T = al256(O_WOUTT + (size_t)1024 * 1024 * 2);
constexpr size_t O_W2T = al256(O_W1T + (size_t)4096 * 1024 * 2);
constexpr size_t O_CTX = al256(O_W2T + (size_t)4096 * 1024 * 2);
constexpr size_t O_ABUF = al256(O_CTX + (size_t)1024 * 1024 * 4);
constexpr size_t O_P = al256(O_ABUF + (size_t)MT * 1024 * 2);
constexpr size_t O_PG = al256(O_P + (size_t)MT * PW * 2);
constexpr size_t O_MIX = al256(O_PG + (size_t)MT * 16 * 4);
constexpr size_t O_HYT = O_MIX;
constexpr size_t O_YHYT = al256(O_HYT + (size_t)768 * MT * 2);
constexpr size_t O_Q = al256(O_YHYT + (size_t)256 * MT * 2);
constexpr size_t O_K = al256(O_Q + (size_t)MT * 512 * 2);
constexpr size_t O_XC = al256(O_K + (size_t)MT * 512 * 2);
constexpr size_t O_CST = al256(O_XC + (size_t)MT * 512 * 2);
constexpr size_t O_XEND = al256(O_CST + (size_t)544 * 129 * 128 * 4);
constexpr size_t S5ST_BYTES = (size_t)2 * 16 * 272 * 64 * 8;
constexpr size_t O_HIN = al256(O_XEND + S5ST_BYTES);
constexpr size_t O_YDIR = al256(O_HIN + S5ST_BYTES);
constexpr size_t O_HDIR = al256(O_YDIR + (size_t)2 * MT * 256 * 4);
constexpr size_t O_MIXEND = al256(O_HDIR + (size_t)2 * MT * 512 * 2);
constexpr size_t O_H1END = al256(O_MIX + (size_t)MT * 4096 * 2);
constexpr size_t WS_NEED = O_MIXEND > O_H1END ? O_MIXEND : O_H1END;

struct Params { const float* in[39]; float* out; unsigned char* ws; };
#define CPR const __attribute__((address_space(4))) Params&
namespace pg8 {
constexpr int BM = 256, BK = 64, HALF = 128, HTB = HALF * BK * 2, STAGE_BYTES = 8 * HTB, NXCD = 8, WGM = 8;
__host__ __device__ __forceinline__ int lds_byte(int r, int c) { const int st = (r >> 4) * 2 + (c >> 5), rr = r & 15, cc = c & 31, ob = rr * 64 + cc * 2; return st * 1024 + (ob ^ (((ob >> 9) & 1) << 5)); }
__host__ __device__ __forceinline__ void stage_rc(int b, int& R, int& C) { const int st = b / 1024, sb = b % 1024, swz = sb ^ (((sb >> 9) & 1) << 5); R = (st >> 1) * 16 + swz / 64; C = (st & 1) * 32 + (swz % 64) / 2; }
struct Unit { int pm, pn, kq; };
struct Gemm { const bf16_t* A; const bf16_t* Bt; int M, N, K, ld; };
struct StaticOrder {
    int nM, nN, nwg, G, c;
    __device__ void init(int M, int N, int G_, int c_) { nM = M / BM; nN = N / BM; nwg = nM * nN; G = G_; c = c_; }
    __device__ bool next(int i, Unit& u) const {
        const long L = (long)i * G + c; if (L >= nwg) return false;
        int wgid = (int)L; { const int q = nwg / NXCD, r = nwg % NXCD, xcd = wgid % NXCD, off = wgid / NXCD; wgid = (xcd < r ? xcd * (q + 1) : r * (q + 1) + (xcd - r) * q) + off; }
        const int nig = WGM * nN, gid = wgid / nig, fm = gid * WGM, gsz = (nM - fm) < WGM ? (nM - fm) : WGM;
        u.pm = fm + ((wgid % nig) % gsz); u.pn = (wgid % nig) / gsz; u.kq = 0; return true;
    }
};
struct CtxSplitOrder {
    int G, c;
    __device__ void init(int G_, int c_) { G = G_; c = c_; }
    __device__ bool next(int i, Unit& u) const { const int L = i * G + c; if (L >= 64) return false; u.kq = L & 3; u.pn = (L >> 2) & 3; u.pm = 64 + (L >> 4); return true; }
};
struct EpiF32 {
    float* C;
    __device__ __forceinline__ void operator()(const f32x4 (&acc)[2][2][4][2], const Unit& u, int wr, int wc, int fr, int fq) const {
        const int row0 = u.pm * BM + wr * 64 + fr, col0 = u.pn * BM + wc * 32 + 4 * fq;
#pragma unroll
        for (int ai = 0; ai < 2; ++ai)
#pragma unroll
            for (int m = 0; m < 4; ++m) { float* rowp = C + (size_t)(row0 + ai * HALF + m * 16) * 1024 + col0;
#pragma unroll
                for (int bj = 0; bj < 2; ++bj)
#pragma unroll
                    for (int n = 0; n < 2; ++n) *(f32x4*)(rowp + bj * HALF + n * 16) = acc[ai][bj][m][n]; }
    }
};
struct EpiF32Split {
    float* Y; float* Ypart;
    __device__ __forceinline__ void operator()(const f32x4 (&acc)[2][2][4][2], const Unit& u, int wr, int wc, int fr, int fq) const {
        const int row0 = u.pm * BM + wr * 64 + fr, col0 = u.pn * BM + wc * 32 + 4 * fq;
        float* C = u.kq == 0 ? Y : Ypart + (size_t)(u.kq - 1) * 1024 * 1024 - (size_t)MLAT * 1024;
#pragma unroll
        for (int ai = 0; ai < 2; ++ai)
#pragma unroll
            for (int m = 0; m < 4; ++m) { float* rowp = C + (size_t)(row0 + ai * HALF + m * 16) * 1024 + col0;
#pragma unroll
                for (int bj = 0; bj < 2; ++bj)
#pragma unroll
                    for (int n = 0; n < 2; ++n) *(f32x4*)(rowp + bj * HALF + n * 16) = acc[ai][bj][m][n]; }
    }
};
struct EpiP {
    bf16_t* P; float* pg;
    __device__ __forceinline__ void operator()(const f32x4 (&acc)[2][2][4][2], const Unit& u, int wr, int wc, int fr, int fq) const {
        const int row0 = u.pm * BM + wr * 64 + fr, col0 = u.pn * BM + wc * 32 + 4 * fq;
        if (u.pn < 10) {
#pragma unroll
            for (int ai = 0; ai < 2; ++ai)
#pragma unroll
                for (int m = 0; m < 4; ++m) { bf16_t* rowp = P + (size_t)(row0 + ai * HALF + m * 16) * PW + col0;
#pragma unroll
                    for (int bj = 0; bj < 2; ++bj)
#pragma unroll
                        for (int n = 0; n < 2; ++n) { const f32x4 v = acc[ai][bj][m][n]; u32x2 o; o.x = cvt_pk_bf16(v[0], v[1]); o.y = cvt_pk_bf16(v[2], v[3]); *(u32x2*)(rowp + bj * HALF + n * 16) = o; } }
        } else if (wc == 0) {
#pragma unroll
            for (int ai = 0; ai < 2; ++ai)
#pragma unroll
                for (int m = 0; m < 4; ++m) *(f32x4*)(pg + (size_t)(row0 + ai * HALF + m * 16) * 16 + 4 * fq) = acc[ai][0][m][0];
        }
    }
};
struct EpiRelu2 {
    bf16_t* O;
    __device__ __forceinline__ void operator()(const f32x4 (&acc)[2][2][4][2], const Unit& u, int wr, int wc, int fr, int fq) const {
        const int row0 = u.pm * BM + wr * 64 + fr, col0 = u.pn * BM + wc * 32 + 4 * fq;
#pragma unroll
        for (int ai = 0; ai < 2; ++ai)
#pragma unroll
            for (int m = 0; m < 4; ++m) { bf16_t* rowp = O + (size_t)(row0 + ai * HALF + m * 16) * 4096 + col0;
#pragma unroll
                for (int bj = 0; bj < 2; ++bj)
#pragma unroll
                    for (int n = 0; n < 2; ++n) { f32x4 v = acc[ai][bj][m][n];
#pragma unroll
                        for (int j = 0; j < 4; ++j) { const float t = fmaxf(v[j], 0.f); v[j] = t * t; }
                        u32x2 o; o.x = cvt_pk_bf16(v[0], v[1]); o.y = cvt_pk_bf16(v[2], v[3]); *(u32x2*)(rowp + bj * HALF + n * 16) = o; } }
    }
};

template <class Epi, class Sched>
__device__ __forceinline__ void gemm_phase(LAS unsigned char* lds, const Gemm g, const Sched& S, const Epi& E) {
    const int tid = ltid(), wid = __builtin_amdgcn_readfirstlane(tid >> 6), lane = tid & 63, wr = wid >> 2, wc = wid & 3, fr = lane & 15, fq = lane >> 4;
    const int K = g.K, nt = K / BK;
    unsigned voffA[2], voffB[2];
#pragma unroll
    for (int i = 0; i < 2; ++i) { int R, C; stage_rc(tid * 16 + i * 8192, R, C); voffA[i] = (unsigned)(R * g.ld + C) * 2u; voffB[i] = voffA[i]; }
    const size_t kstep = (size_t)(BK * 2);
    const size_t hstep = (size_t)HALF * g.ld * 2;
    const size_t qstep = (size_t)K * 2;
    const size_t tstep = 2 * hstep;
    const unsigned ldsw = (unsigned)wid * 1024u;
    const int aoff = lds_byte(wr * 64 + fr, fq * 8), boff = lds_byte(wc * 32 + fr, fq * 8);
#define PG8_SA(b, h) (((b) * 2 + (h)) * HTB)
#define PG8_SB(b, h) ((4 + (b) * 2 + (h)) * HTB)
#define PG8_STAGE(bufoff, gbase, voff) do { _Pragma("unroll") for (int _i = 0; _i < 2; ++_i) \
        __builtin_amdgcn_global_load_lds((const unsigned*)((const char*)(gbase) + (voff)[_i]), (LAS unsigned*)(lds + (bufoff) + ldsw + _i * 8192), 16, 0, 0); } while (0)
#define PG8_LDA(dst, b, h) do { _Pragma("unroll") for (int m = 0; m < 4; ++m) _Pragma("unroll") for (int k = 0; k < 2; ++k) dst[m][k] = *(const LAS bf16x8*)(lds + PG8_SA(b, h) + aoff + m * 2048 + k * 1024); } while (0)
#define PG8_LDB(dst, b, h) do { _Pragma("unroll") for (int n = 0; n < 2; ++n) _Pragma("unroll") for (int k = 0; k < 2; ++k) dst[n][k] = *(const LAS bf16x8*)(lds + PG8_SB(b, h) + boff + n * 2048 + k * 1024); } while (0)
#define PG8_MMA(ai, bj, At, Bt) do { __builtin_amdgcn_s_setprio(1); _Pragma("unroll") for (int m = 0; m < 4; ++m) _Pragma("unroll") for (int n = 0; n < 2; ++n) _Pragma("unroll") for (int k = 0; k < 2; ++k) \
        acc[ai][bj][m][n] = __builtin_amdgcn_mfma_f32_16x16x32_bf16(Bt[n][k], At[m][k], acc[ai][bj][m][n], 0, 0, 0); __builtin_amdgcn_s_setprio(0); } while (0)
#define PG8_WAIT_V(n) asm volatile("s_waitcnt vmcnt(" #n ")" ::: "memory")
#define PG8_WAIT_L(n) asm volatile("s_waitcnt lgkmcnt(" #n ")" ::: "memory")
#define PG8_BAR __builtin_amdgcn_s_barrier()
#define PG8_SCHED __builtin_amdgcn_sched_barrier(0)
    Unit cur, nxt; int ui = 0;
    if (!S.next(0, cur)) return;
    f32x4 acc[2][2][4][2];
#pragma unroll
    for (int a = 0; a < 2; ++a)
#pragma unroll
        for (int b = 0; b < 2; ++b)
#pragma unroll
            for (int m = 0; m < 4; ++m)
#pragma unroll
                for (int n = 0; n < 2; ++n) acc[a][b][m][n] = (f32x4){0.f, 0.f, 0.f, 0.f};
    bf16x8 At[4][2], B0[2][2], B1[2][2];
    const char* cA = (const char*)g.A + (size_t)cur.pm * tstep + (size_t)cur.kq * qstep; const char* cB = (const char*)g.Bt + (size_t)cur.pn * tstep + (size_t)cur.kq * qstep;
    PG8_STAGE(PG8_SB(0, 0), cB, voffB); PG8_STAGE(PG8_SA(0, 0), cA, voffA); PG8_STAGE(PG8_SB(0, 1), cB + hstep, voffB); PG8_STAGE(PG8_SA(0, 1), cA + hstep, voffA);
    if (wr == 1) PG8_BAR;
    PG8_WAIT_V(4); PG8_BAR;
    PG8_STAGE(PG8_SB(1, 0), cB + kstep, voffB); PG8_STAGE(PG8_SA(1, 0), cA + kstep, voffA); PG8_STAGE(PG8_SB(1, 1), cB + hstep + kstep, voffB);
    PG8_WAIT_V(6); PG8_BAR;
    for (;;) {
        const bool has_next = S.next(ui + 1, nxt);
        const char* nA = has_next ? (const char*)g.A + (size_t)nxt.pm * tstep + (size_t)nxt.kq * qstep : cA; const char* nB = has_next ? (const char*)g.Bt + (size_t)nxt.pn * tstep + (size_t)nxt.kq * qstep : cB;
        for (int t = 0; t < nt; t += 2) {
            const bool last = (t == nt - 2);
            const char* a1 = cA + (size_t)(t + 1) * kstep;
            const char* a2 = last ? nA : cA + (size_t)(t + 2) * kstep; const char* b2 = last ? nB : cB + (size_t)(t + 2) * kstep;
            const char* a3 = a2 + kstep; const char* b3 = b2 + kstep;
            PG8_LDB(B0, 0, 0); PG8_SCHED; PG8_LDA(At, 0, 0); PG8_STAGE(PG8_SA(1, 1), a1 + hstep, voffA);
            PG8_WAIT_L(8); PG8_BAR; PG8_WAIT_L(0); PG8_MMA(0, 0, At, B0); PG8_BAR; PG8_SCHED;
            PG8_LDB(B1, 0, 1); PG8_STAGE(PG8_SB(0, 0), b2, voffB);
            PG8_BAR; PG8_WAIT_L(0); PG8_MMA(0, 1, At, B1); PG8_BAR;
            PG8_LDA(At, 0, 1); PG8_STAGE(PG8_SA(0, 0), a2, voffA);
            PG8_BAR; PG8_WAIT_L(0); PG8_MMA(1, 0, At, B0); PG8_BAR; PG8_SCHED;
            PG8_STAGE(PG8_SB(0, 1), b2 + hstep, voffB);
            PG8_WAIT_V(6); PG8_BAR; PG8_MMA(1, 1, At, B1); PG8_BAR;
            PG8_LDB(B0, 1, 0); PG8_SCHED; PG8_LDA(At, 1, 0); PG8_STAGE(PG8_SA(0, 1), a2 + hstep, voffA);
            PG8_WAIT_L(8); PG8_BAR; PG8_WAIT_L(0); PG8_MMA(0, 0, At, B0); PG8_BAR; PG8_SCHED;
            PG8_LDB(B1, 1, 1); PG8_STAGE(PG8_SB(1, 0), b3, voffB);
            PG8_BAR; PG8_WAIT_L(0); PG8_MMA(0, 1, At, B1); PG8_BAR;
            PG8_LDA(At, 1, 1); PG8_STAGE(PG8_SA(1, 0), a3, voffA);
            PG8_BAR; PG8_WAIT_L(0); PG8_MMA(1, 0, At, B0); PG8_BAR; PG8_SCHED;
            PG8_STAGE(PG8_SB(1, 1), b3 + hstep, voffB);
            PG8_WAIT_V(6); PG8_BAR; PG8_MMA(1, 1, At, B1); PG8_BAR;
        }
        E(acc, cur, wr, wc, fr, fq);
        if (!has_next) break;
#pragma unroll
        for (int a = 0; a < 2; ++a)
#pragma unroll
            for (int b = 0; b < 2; ++b)
#pragma unroll
                for (int m = 0; m < 4; ++m)
#pragma unroll
                    for (int n = 0; n < 2; ++n) acc[a][b][m][n] = (f32x4){0.f, 0.f, 0.f, 0.f};
        cur = nxt; cA = nA; cB = nB; ++ui;
    }
    PG8_WAIT_V(0);
    if (wr == 0) PG8_BAR;
    PG8_BAR;
#undef PG8_SA
#undef PG8_SB
#undef PG8_STAGE
#undef PG8_LDA
#undef PG8_LDB
#undef PG8_MMA
#undef PG8_WAIT_V
#undef PG8_WAIT_L
#undef PG8_BAR
#undef PG8_SCHED
}
}
__device__ __forceinline__ int first_item(int off, int G) { int r = ((int)blockIdx.x - off) % G; if (r < 0) r += G; return r; }

__device__ __forceinline__ void phase_mod(CPR p, LAS unsigned char* lds) {
  LAS float* sc = (LAS float*)lds;
  LAS float* part = sc + 5 * 1024;
  const int tid = ltid(), wid = tid >> 6, lane = tid & 63;
  for (int i = tid; i < 5 * 1024; i += NTHR) {
    const int r = i >> 10, k = i & 1023;
    const float v = (r < 4) ? p.in[1][r * 1024 + k] : p.in[3][k];
    sc[i] = v / (1.f + __expf(-v));
  }
  __syncthreads();
  float* modt = (float*)(p.ws + O_MOD);
  for (int it = blockIdx.x; it < DEPTH * 96; it += gridDim.x) {
    const int l = it / 96, col = (it % 96) * 64 + lane;
    const float* w = p.in[4] + ((size_t)l * 1024 + wid * 128) * 6144 + col;
    float a0 = 0.f, a1 = 0.f, a2 = 0.f, a3 = 0.f, a4 = 0.f;
#pragma unroll 8
    for (int k = 0; k < 128; ++k) {
      const float wv = w[(size_t)k * 6144];
      const int kk = wid * 128 + k;
      a0 += sc[kk] * wv; a1 += sc[1024 + kk] * wv; a2 += sc[2048 + kk] * wv; a3 += sc[3072 + kk] * wv; a4 += sc[4096 + kk] * wv;
    }
    part[(wid * 5 + 0) * 64 + lane] = a0; part[(wid * 5 + 1) * 64 + lane] = a1; part[(wid * 5 + 2) * 64 + lane] = a2; part[(wid * 5 + 3) * 64 + lane] = a3; part[(wid * 5 + 4) * 64 + lane] = a4;
    __syncthreads();
    if (wid < 5) {
      float s = p.in[5][l * 6144 + col];
#pragma unroll
      for (int w8 = 0; w8 < 8; ++w8) s += part[(w8 * 5 + wid) * 64 + lane];
      modt[((size_t)l * 5 + wid) * 6144 + col] = s;
    }
    __syncthreads();
  }
}

__device__ __forceinline__ void conv_tile(LAS unsigned char* lds, const float* src, int ldsrc, int nvalid, bf16_t* dst, int K, int kt, int nt) {
  LAS float* T = (LAS float*)lds;
  __syncthreads();
  {
    const int j4 = (ltid() & 15) * 4, i0 = ltid() >> 4;
#pragma unroll
    for (int pss = 0; pss < 2; ++pss) {
      const int i = i0 + pss * 32;
      const int col = nt * 64 + j4;
      float4 v = make_float4(0.f, 0.f, 0.f, 0.f);
      if (col + 3 < nvalid) v = *(const float4*)(src + (size_t)(kt * 64 + i) * ldsrc + col);
      else { const float* s = src + (size_t)(kt * 64 + i) * ldsrc; if (col < nvalid) v.x = s[col]; if (col + 1 < nvalid) v.y = s[col + 1]; if (col + 2 < nvalid) v.z = s[col + 2]; }
      T[(j4 + 0) * 65 + i] = v.x; T[(j4 + 1) * 65 + i] = v.y; T[(j4 + 2) * 65 + i] = v.z; T[(j4 + 3) * 65 + i] = v.w;
    }
  }
  __syncthreads();
  {
    const int j = ltid() >> 3, i8 = (ltid() & 7) * 8;
    u32x4 o;
    o.x = cvt_pk_bf16(T[j * 65 + i8 + 0], T[j * 65 + i8 + 1]); o.y = cvt_pk_bf16(T[j * 65 + i8 + 2], T[j * 65 + i8 + 3]);
    o.z = cvt_pk_bf16(T[j * 65 + i8 + 4], T[j * 65 + i8 + 5]); o.w = cvt_pk_bf16(T[j * 65 + i8 + 6], T[j * 65 + i8 + 7]);
    *(u32x4*)(dst + (size_t)(nt * 64 + j) * K + kt * 64 + i8) = o;
  }
}

__device__ __forceinline__ void conv_tile4(LAS unsigned char* lds, const float* src, int ldsrc, int nvalid, bf16_t* dst, int K, int kt, int nt4) {
  LAS float* T = (LAS float*)lds;
  __syncthreads();
  {
    const int j4 = (ltid() & 15) * 4, i0 = ltid() >> 4;
    float4 v[4][2];
#pragma unroll
    for (int s4 = 0; s4 < 4; ++s4)
#pragma unroll
      for (int pss = 0; pss < 2; ++pss) {
        const int i = i0 + pss * 32; const int col = (nt4 * 4 + s4) * 64 + j4;
        v[s4][pss] = make_float4(0.f, 0.f, 0.f, 0.f);
        if (col + 3 < nvalid) v[s4][pss] = *(const float4*)(src + (size_t)(kt * 64 + i) * ldsrc + col);
      }
#pragma unroll
    for (int s4 = 0; s4 < 4; ++s4)
#pragma unroll
      for (int pss = 0; pss < 2; ++pss) {
        const int i = i0 + pss * 32; LAS float* Ts = T + s4 * 64 * 65;
        Ts[(j4 + 0) * 65 + i] = v[s4][pss].x; Ts[(j4 + 1) * 65 + i] = v[s4][pss].y; Ts[(j4 + 2) * 65 + i] = v[s4][pss].z; Ts[(j4 + 3) * 65 + i] = v[s4][pss].w;
      }
  }
  __syncthreads();
  {
    const int j = ltid() >> 3, i8 = (ltid() & 7) * 8;
#pragma unroll
    for (int s4 = 0; s4 < 4; ++s4) {
      LAS const float* Ts = T + s4 * 64 * 65 + j * 65 + i8;
      u32x4 o;
      o.x = cvt_pk_bf16(Ts[0], Ts[1]); o.y = cvt_pk_bf16(Ts[2], Ts[3]); o.z = cvt_pk_bf16(Ts[4], Ts[5]); o.w = cvt_pk_bf16(Ts[6], Ts[7]);
      *(u32x4*)(dst + (size_t)((nt4 * 4 + s4) * 64 + j) * K + kt * 64 + i8) = o;
    }
  }
}

constexpr int NCONV = 176 + 64 + 256 + 256 + 4 + 32;
__device__ __forceinline__ void conv_item(CPR p, LAS unsigned char* lds, int l, int it) {
  unsigned char* ws = p.ws;
  if (it < 176) { conv_tile4(lds, p.in[10] + (size_t)l * 1024 * PWF, PWF, PWF, (bf16_t*)(ws + O_WINT), 1024, it / 11, it % 11); return; }
  it -= 176;
  if (it < 64) { conv_tile4(lds, p.in[11] + (size_t)l * 1024 * 1024, 1024, 1024, (bf16_t*)(ws + O_WOUTT), 1024, it / 4, it % 4); return; }
  it -= 64;
  if (it < 256) { conv_tile4(lds, p.in[37] + (size_t)l * 1024 * 4096, 4096, 4096, (bf16_t*)(ws + O_W1T), 1024, it / 16, it % 16); return; }
  it -= 256;
  if (it < 256) { conv_tile4(lds, p.in[38] + (size_t)l * 4096 * 1024, 1024, 1024, (bf16_t*)(ws + O_W2T), 4096, it / 4, it % 4); return; }
  it -= 256;
  if (it < 4) { conv_tile4(lds, p.in[29] + (size_t)l * 256 * 256, 256, 256, (bf16_t*)(ws + O_WGLUT + SM(l)), 256, it, 0); return; }
  it -= 4;
  { const int which = it >> 4, h = (it >> 2) & 3, kt = (it >> 1) & 1, nt = it & 1;
    conv_tile(lds, p.in[which ? 33 : 32] + ((size_t)l * 4 + h) * 128 * 128, 128, 128, (bf16_t*)(ws + (which ? O_WKT : O_WQT) + SM(l)) + (size_t)h * 128 * 128, 128, kt, nt); }
}

__device__ __forceinline__ void hyfilt_item(CPR p, LAS unsigned char* lds, int l, int it) {
  const int which = it >= 256 ? 1 : 0; const int tt = which ? it - 256 : it; const int Ls = which ? CTXL : SEQL;
  LAS float* feat = (LAS float*)lds;
  LAS float* h1 = feat + 16 * 20;
  LAS float* h2 = h1 + 16 * 64;
  const int tid = ltid();
  __syncthreads();
  if (tid < 16 * 17) {
    const int i = tid / 17, e = tid % 17; const float t = (float)(tt * 16 + i) / (float)Ls;
    float v;
    if (e == 0) v = t; else if (e <= 8) v = cosf(6.283185307179586f * t * (float)e); else v = sinf(6.283185307179586f * t * (float)(e - 8));
    feat[i * 20 + e] = v;
  }
  __syncthreads();
  const float* w1 = p.in[13] + (size_t)l * 17 * 64; const float* b1 = p.in[14] + l * 64; const float* w2 = p.in[15] + (size_t)l * 64 * 64; const float* b2 = p.in[16] + l * 64;
  const float* w3 = p.in[17] + (size_t)l * 64 * 1024; const float* fr = p.in[18] + l * 64; const float* dec = p.in[19] + (size_t)l * 1024;
#pragma unroll 1
  for (int o = tid; o < 1024; o += NTHR) { const int i = o >> 6, f = o & 63; float a = b1[f];
#pragma unroll 1
    for (int e = 0; e < 17; ++e) a += feat[i * 20 + e] * w1[e * 64 + f];
    h1[o] = sinf(fr[f] * a); }
  __syncthreads();
#pragma unroll 1
  for (int o = tid; o < 1024; o += NTHR) { const int i = o >> 6, f = o & 63; float a = b2[f];
#pragma unroll 4
    for (int e = 0; e < 64; ++e) a += h1[i * 64 + e] * w2[e * 64 + f];
    h2[o] = sinf(fr[f] * a); }
  __syncthreads();
  float* hpart = (float*)(p.ws + O_HPART + SM(l)) + ((size_t)which * 256 + tt) * 1024;
  bf16_t* hout = (bf16_t*)(p.ws + (which ? O_HFCTX : O_HFLAT));
#pragma unroll 1
  for (int cc = 0; cc < 2; ++cc) {
    const int col = tid + cc * 512;
    float acc[16];
#pragma unroll
    for (int i = 0; i < 16; ++i) acc[i] = 0.f;
#pragma unroll 2
    for (int f = 0; f < 64; ++f) { const float w = w3[f * 1024 + col];
#pragma unroll
      for (int i = 0; i < 16; ++i) acc[i] += h2[i * 64 + f] * w; }
    const float dc = dec[col]; float ss = 0.f;
#pragma unroll
    for (int i = 0; i < 16; ++i) { const float t = (float)(tt * 16 + i) / (float)Ls; acc[i] *= expf(-t * dc); ss += acc[i] * acc[i]; }
    hpart[col] = ss;
    u32x4 o0, o1;
    o0.x = cvt_pk_bf16(acc[0], acc[1]); o0.y = cvt_pk_bf16(acc[2], acc[3]); o0.z = cvt_pk_bf16(acc[4], acc[5]); o0.w = cvt_pk_bf16(acc[6], acc[7]);
    o1.x = cvt_pk_bf16(acc[8], acc[9]); o1.y = cvt_pk_bf16(acc[10], acc[11]); o1.z = cvt_pk_bf16(acc[12], acc[13]); o1.w = cvt_pk_bf16(acc[14], acc[15]);
    bf16_t* d = hout + (size_t)col * Ls + tt * 16;
    *(u32x4*)d = o0; *(u32x4*)(d + 8) = o1;
  }
}

__device__ __forceinline__ void s5tab_item(CPR p, int l, int it) {
  const int idx = it * NTHR + ltid();
  const int n = idx & 63, dg = idx >> 6;
  const size_t base = (size_t)l * 2048 + idx;
  const float are = p.in[21][base], aim = p.in[22][base];
  const float dt = expf(p.in[23][l * 32 + dg]);
  const float zr = are * dt, zi = aim * dt;
  const float er = expf(zr), cs = cosf(zi), sn = sinf(zi);
  const float abr = er * cs, abi = er * sn;
  const float e64 = expf(64.f * zr), c64 = cosf(64.f * zi), s64 = sinf(64.f * zi);
  float* ab = (float*)(p.ws + O_S5AB + SM(l)) + (size_t)idx * 4;
  ab[0] = abr; ab[1] = abi; ab[2] = e64 * c64; ab[3] = e64 * s64;
  const float sh = sinf(0.5f * zi);
  const float mr = expm1f(zr) * cs - 2.f * sh * sh, mi = er * sn;
  const float den = 1.f / (are * are + aim * aim);
  const float cr = (mr * are + mi * aim) * den, ci = (mi * are - mr * aim) * den;
  bf16_t* bbt = (bf16_t*)(p.ws + O_BBT + SM(l)) + ((size_t)dg * 128 + 2 * n) * 16;
  const float* bre = p.in[24] + base * 16; const float* bim = p.in[25] + base * 16;
#pragma unroll
  for (int c = 0; c < 16; ++c) { const float br = bre[c], bi = bim[c]; bbt[c] = f2bf(cr * br - ci * bi); bbt[16 + c] = f2bf(cr * bi + ci * br); }
  bf16_t* cmt = (bf16_t*)(p.ws + O_CMT + SM(l)) + (size_t)dg * 16 * 128;
  const float* cre = p.in[26] + ((size_t)l * 32 + dg) * 1024; const float* cim = p.in[27] + ((size_t)l * 32 + dg) * 1024;
#pragma unroll
  for (int c = 0; c < 16; ++c) { cmt[c * 128 + 2 * n] = f2bf(cre[c * 64 + n]); cmt[c * 128 + 2 * n + 1] = f2bf(-cim[c * 64 + n]); }
}

struct RowCfg {
  const float* srcL; const float* srcC; float* dstL; float* dstC;
  const float* Y; const float* ypart; const float* gpost; const float* modA; int gate_off;
  const float* gpre; const float* modB; int sc_off, sh_off; bf16_t* abuf;
};
__device__ __forceinline__ void row_item(const RowCfg& c, int row) {
  const int lane = ltid() & 63;
  const bool isctx = row >= MLAT;
  const int mr = isctx ? 4 : (row >> 12);
  const float* src = isctx ? c.srcC + (size_t)(row - MLAT) * 1024 : c.srcL + (size_t)row * 1024;
  float* dst = isctx ? c.dstC + (size_t)(row - MLAT) * 1024 : c.dstL + (size_t)row * 1024;
  float4 x[4];
#pragma unroll
  for (int j = 0; j < 4; ++j) x[j] = *(const float4*)(src + j * 256 + lane * 4);
  if (c.Y) {
    float4 y[4]; float ss = 0.f;
#pragma unroll
    for (int j = 0; j < 4; ++j) { y[j] = *(const float4*)(c.Y + (size_t)row * 1024 + j * 256 + lane * 4);
      if (isctx && c.ypart) {
#pragma unroll
        for (int q = 0; q < 3; ++q) { const float4 t = *(const float4*)(c.ypart + ((size_t)q * 1024 + (row - MLAT)) * 1024 + j * 256 + lane * 4); y[j].x += t.x; y[j].y += t.y; y[j].z += t.z; y[j].w += t.w; }
      }
      ss += y[j].x * y[j].x + y[j].y * y[j].y + y[j].z * y[j].z + y[j].w * y[j].w; }
    ss = wave_sum(ss);
    const float r = rsqrtf(ss * (1.f / 1024.f) + EPS);
#pragma unroll
    for (int j = 0; j < 4; ++j) {
      const int col = j * 256 + lane * 4;
      const float4 gp = *(const float4*)(c.gpost + col); const float4 gt = *(const float4*)(c.modA + (size_t)mr * 6144 + c.gate_off + col);
      x[j].x += gt.x * (y[j].x * r * gp.x); x[j].y += gt.y * (y[j].y * r * gp.y); x[j].z += gt.z * (y[j].z * r * gp.z); x[j].w += gt.w * (y[j].w * r * gp.w);
    }
  }
  if (c.Y || dst != src) {
#pragma unroll
    for (int j = 0; j < 4; ++j) *(float4*)(dst + j * 256 + lane * 4) = x[j];
  }
  if (c.gpre) {
    float ss = 0.f;
#pragma unroll
    for (int j = 0; j < 4; ++j) ss += x[j].x * x[j].x + x[j].y * x[j].y + x[j].z * x[j].z + x[j].w * x[j].w;
    ss = wave_sum(ss);
    const float r = rsqrtf(ss * (1.f / 1024.f) + EPS);
#pragma unroll
    for (int j = 0; j < 4; ++j) {
      const int col = j * 256 + lane * 4;
      const float4 gp = *(const float4*)(c.gpre + col);
      const float4 s = *(const float4*)(c.modB + (size_t)mr * 6144 + c.sc_off + col); const float4 h = *(const float4*)(c.modB + (size_t)mr * 6144 + c.sh_off + col);
      u32x2 o;
      o.x = cvt_pk_bf16(x[j].x * r * gp.x * (1.f + s.x) + h.x, x[j].y * r * gp.y * (1.f + s.y) + h.y);
      o.y = cvt_pk_bf16(x[j].z * r * gp.z * (1.f + s.z) + h.z, x[j].w * r * gp.w * (1.f + s.w) + h.w);
      *(u32x2*)(c.abuf + (size_t)row * 1024 + col) = o;
    }
  }
}
#define MFMA16(a, b, c) __builtin_amdgcn_mfma_f32_16x16x32_bf16(a, b, c, 0, 0, 0)
#define MFMA32(a, b, c) __builtin_amdgcn_mfma_f32_32x32x16_bf16(a, b, c, 0, 0, 0)

__device__ __forceinline__ void hyshort_item(CPR p, LAS unsigned char* lds, int l, int it) {
  const int ch = it / 3, cg4 = it % 3;
  const bf16_t* P = (const bf16_t*)(p.ws + O_P); bf16_t* hyT = (bf16_t*)(p.ws + O_HYT);
  LAS bf16_t* T = (LAS bf16_t*)lds;
  const int tid = ltid();
  const int tc = ch < 256 ? (ch & 63) : ((ch - 256) & 3); const int nch = ch < 256 ? 64 : 4;
  __syncthreads();
  {
    const int tau = tid >> 3, cb = (tid & 7) * 8; const int row = ch * 64 + tau;
    const bool hasm = !(tc == 0 && tau == 0), hasp = !(tc == nch - 1 && tau == 63);
    const bf16x8 zero = {0, 0, 0, 0, 0, 0, 0, 0};
    bf16x8 v0[4], vm[4], vp[4];
#pragma unroll
    for (int s4 = 0; s4 < 4; ++s4) { const int c0 = cg4 * 256 + s4 * 64 + cb;
      v0[s4] = *(const bf16x8*)(P + (size_t)row * PW + c0);
      vm[s4] = hasm ? *(const bf16x8*)(P + (size_t)(row - 1) * PW + c0) : zero;
      vp[s4] = hasp ? *(const bf16x8*)(P + (size_t)(row + 1) * PW + c0) : zero; }
#pragma unroll
    for (int s4 = 0; s4 < 4; ++s4) { const int c0 = cg4 * 256 + s4 * 64 + cb;
      const float* w = p.in[12] + (size_t)l * 3 * 768 + c0;
#pragma unroll
      for (int j = 0; j < 8; ++j) {
        const float o = w[j] * bf2f((bf16_t)vm[s4][j]) + w[768 + j] * bf2f((bf16_t)v0[s4][j]) + w[1536 + j] * bf2f((bf16_t)vp[s4][j]);
        T[(s4 * 64 + cb + j) * 72 + tau] = f2bf(o);
      } }
  }
  __syncthreads();
  {
    const int c = tid >> 3, t8 = (tid & 7) * 8;
#pragma unroll
    for (int s4 = 0; s4 < 4; ++s4) {
      const u32x4 v = *(const LAS u32x4*)(T + (s4 * 64 + c) * 72 + t8);
      *(u32x4*)(hyT + (size_t)(cg4 * 256 + s4 * 64 + c) * MT + ch * 64 + t8) = v; }
  }
}

__device__ __forceinline__ void mlqk_item(CPR p, LAS unsigned char* lds, int l, int it) {
  const int ch = it >> 2, h = it & 3;
  const bf16_t* P = (const bf16_t*)(p.ws + O_P);
  bf16_t* qb = (bf16_t*)(p.ws + O_Q); bf16_t* kb = (bf16_t*)(p.ws + O_K); bf16_t* xcb = (bf16_t*)(p.ws + O_XC);
  LAS bf16_t* XA = (LAS bf16_t*)lds;
  LAS bf16_t* WQ = XA + 64 * 136;
  LAS bf16_t* WK = WQ + 128 * 136;
  const int tid = ltid(), wid = tid >> 6, lane = tid & 63, cl = lane & 15, quad = lane >> 4;
  __syncthreads();
  {
    const bf16_t* wq = (const bf16_t*)(p.ws + O_WQT + SM(l)) + (size_t)h * 16384; const bf16_t* wk = (const bf16_t*)(p.ws + O_WKT + SM(l)) + (size_t)h * 16384;
    for (int i = tid; i < 2048; i += NTHR) { const int r = i >> 4, c8 = (i & 15) * 8;
      *(LAS u32x4*)(WQ + r * 136 + c8) = *(const u32x4*)(wq + r * 128 + c8); *(LAS u32x4*)(WK + r * 136 + c8) = *(const u32x4*)(wk + r * 128 + c8); }
  }
  {
    const int tau = tid >> 3, cb = (tid & 7) * 16; const int cch = h * 128 + cb;
    const bool lat = ch < 256;
    const int seqbase = lat ? (ch >> 6) * 4096 : MLAT + ((ch - 256) >> 2) * 256;
    const int tloc = lat ? (ch & 63) * 64 + tau : ((ch - 256) & 3) * 64 + tau;
    const float* cw = p.in[31] + (size_t)l * 9 * 512 + cch;
    float acc[16];
#pragma unroll
    for (int j = 0; j < 16; ++j) acc[j] = 0.f;
#pragma unroll
    for (int di = 0; di < 3; ++di) {
      if (!lat && di != 1) continue;
#pragma unroll
      for (int dj = 0; dj < 3; ++dj) {
        bool ok; int ts;
        if (lat) { const int r = (tloc >> 6) + di - 1, cc = (tloc & 63) + dj - 1; ok = (r >= 0 && r < 64 && cc >= 0 && cc < 64); ts = r * 64 + cc; }
        else { ts = tloc + dj - 1; ok = (ts >= 0 && ts < 256); }
        if (ok) {
          const bf16_t* src = P + (size_t)(seqbase + ts) * PW + 1024 + cch;
          const bf16x8 v0 = *(const bf16x8*)src, v1 = *(const bf16x8*)(src + 8);
          const float* w = cw + (di * 3 + dj) * 512;
#pragma unroll
          for (int j = 0; j < 8; ++j) { acc[j] += w[j] * bf2f((bf16_t)v0[j]); acc[8 + j] += w[8 + j] * bf2f((bf16_t)v1[j]); }
        }
      }
    }
#pragma unroll
    for (int j = 0; j < 16; ++j) acc[j] = acc[j] / (1.f + __expf(-acc[j]));
    u32x4 o0, o1;
    o0.x = cvt_pk_bf16(acc[0], acc[1]); o0.y = cvt_pk_bf16(acc[2], acc[3]); o0.z = cvt_pk_bf16(acc[4], acc[5]); o0.w = cvt_pk_bf16(acc[6], acc[7]);
    o1.x = cvt_pk_bf16(acc[8], acc[9]); o1.y = cvt_pk_bf16(acc[10], acc[11]); o1.z = cvt_pk_bf16(acc[12], acc[13]); o1.w = cvt_pk_bf16(acc[14], acc[15]);
    *(LAS u32x4*)(XA + tau * 136 + cb) = o0; *(LAS u32x4*)(XA + tau * 136 + cb + 8) = o1;
    bf16_t* xo = xcb + (size_t)(ch * 64 + tau) * 512 + cch;
    *(u32x4*)xo = o0; *(u32x4*)(xo + 8) = o1;
  }
  __syncthreads();
#pragma unroll 1
  for (int ti = 0; ti < 8; ++ti) {
    const int t = wid * 8 + ti; const int mat = t >> 5, rt = (t >> 3) & 3, ct = t & 7;
    LAS const bf16_t* W = mat ? WK : WQ;
    f32x4 acc = {0.f, 0.f, 0.f, 0.f};
#pragma unroll
    for (int ks = 0; ks < 4; ++ks) {
      const bf16x8 a = *(LAS const bf16x8*)(XA + (rt * 16 + cl) * 136 + ks * 32 + quad * 8);
      const bf16x8 b = *(LAS const bf16x8*)(W + (ct * 16 + cl) * 136 + ks * 32 + quad * 8);
      acc = MFMA16(a, b, acc);
    }
    bf16_t* o = (mat ? kb : qb) + (size_t)(ch * 64 + rt * 16 + quad * 4) * 512 + h * 128 + ct * 16 + cl;
    const float sc = mat ? 0.08838834764831845f : 1.f;
#pragma unroll
    for (int i = 0; i < 4; ++i) o[(size_t)i * 512] = f2bf(acc[i] * sc);
  }
}

template <bool OUT>
__device__ __forceinline__ void s5_chunk(CPR p, LAS unsigned char* Lw, int wi, int l, bool first) {
  const int lane = ltid() & 63, cl = lane & 15, quad = lane >> 4;
  const int dg = wi / 272, ch = wi % 272; const int dir = dg >> 4, g = dg & 15;
  const bf16_t* P = (const bf16_t*)(p.ws + O_P);
  LAS float* BUs = (LAS float*)Lw;
  LAS bf16_t* Xs = (LAS bf16_t*)(Lw + 16 * 132 * 4);
  const bf16x8 zero = {0, 0, 0, 0, 0, 0, 0, 0};
  bf16x8 bb[8];
  const bf16_t* bbt = (const bf16_t*)(p.ws + O_BBT + SM(l)) + (size_t)dg * 128 * 16;
#pragma unroll
  for (int j = 0; j < 8; ++j) bb[j] = quad < 2 ? *(const bf16x8*)(bbt + (16 * j + cl) * 16 + 8 * quad) : zero;
  bf16x8 cf[4];
  if (OUT) { const bf16_t* cmt = (const bf16_t*)(p.ws + O_CMT + SM(l)) + (size_t)dg * 16 * 128;
#pragma unroll
    for (int kk = 0; kk < 4; ++kk) cf[kk] = *(const bf16x8*)(cmt + cl * 128 + 32 * kk + 8 * quad); }
  const float* ab = (const float*)(p.ws + O_S5AB + SM(l)) + ((size_t)dg * 64 + lane) * 4;
  const float ar = ab[0], ai = ab[1];
  float xr = 0.f, xi = 0.f;
  const size_t sidx = ((size_t)dg * 272 + ch) * 64 + lane;
  if (OUT && !first) { const float2 h0 = ((const float2*)(p.ws + O_HIN))[sidx]; xr = h0.x; xi = h0.y; }
  float* Yd = (float*)(p.ws + O_YDIR) + (size_t)dg * MT * 16;
#pragma unroll 1
  for (int sb = 0; sb < 4; ++sb) {
    const int pos = 16 * sb + cl; const int tok = dir ? 63 - pos : pos;
    const bf16x8 a = quad < 2 ? *(const bf16x8*)(P + (size_t)(ch * 64 + tok) * PW + 768 + g * 16 + 8 * quad) : zero;
#pragma unroll
    for (int j = 0; j < 8; ++j) {
      f32x4 acc = {0.f, 0.f, 0.f, 0.f};
      acc = MFMA16(a, bb[j], acc);
#pragma unroll
      for (int i = 0; i < 4; ++i) BUs[(quad * 4 + i) * 132 + 16 * j + cl] = acc[i];
    }
    lds_wait();
#pragma unroll
    for (int t = 0; t < 16; ++t) {
      const f32x2 bu = *(LAS const f32x2*)(BUs + t * 132 + 2 * lane);
      float nr = ar * xr - ai * xi + bu.x, ni = ar * xi + ai * xr + bu.y;
      asm volatile("" : "+v"(nr), "+v"(ni));
      xr = nr; xi = ni;
      if (OUT && !first) *(LAS unsigned*)(Xs + t * 136 + 2 * lane) = cvt_pk_bf16(xr, xi);
    }
    if (OUT && !first) {
      lds_wait();
      f32x4 acc = {0.f, 0.f, 0.f, 0.f};
#pragma unroll
      for (int kk = 0; kk < 4; ++kk) { const bf16x8 af = *(LAS const bf16x8*)(Xs + cl * 136 + 32 * kk + 8 * quad); acc = MFMA16(af, cf[kk], acc); }
#pragma unroll
      for (int i = 0; i < 4; ++i) { const int ps = 16 * sb + quad * 4 + i; const int tk = dir ? 63 - ps : ps; Yd[(size_t)(ch * 64 + tk) * 16 + cl] = acc[i]; }
    }
    lds_wait();
  }
  if (!OUT || first) ((float2*)(p.ws + O_XEND))[sidx] = make_float2(xr, xi);
}

__device__ __forceinline__ void s5_carry_item(CPR p, int it, int l) {
  const int idx = it * NTHR + ltid();
  const int n = idx & 63, g = (idx >> 6) & 15, b = (idx >> 10) & 3, dir = idx >> 12;
  const int dg = dir * 16 + g;
  const float* ab = (const float*)(p.ws + O_S5AB + SM(l)) + ((size_t)dg * 64 + n) * 4;
  const float ar = ab[2], ai = ab[3];
  const float2* xe = (const float2*)(p.ws + O_XEND) + (size_t)dg * 272 * 64 + n; float2* hin = (float2*)(p.ws + O_HIN) + (size_t)dg * 272 * 64 + n;
  float hr = 0.f, hi = 0.f;
#pragma unroll 1
  for (int base = 0; base < 68; base += 17) {
    float2 e[17];
#pragma unroll
    for (int j = 0; j < 17; ++j) { const int sp = base + j; const int ch = sp < 4 ? 256 + b * 4 + (dir ? 3 - sp : sp) : b * 64 + (dir ? 63 - (sp - 4) : sp - 4); e[j] = xe[(size_t)ch * 64]; }
#pragma unroll
    for (int j = 0; j < 17; ++j) { const int sp = base + j; const int ch = sp < 4 ? 256 + b * 4 + (dir ? 3 - sp : sp) : b * 64 + (dir ? 63 - (sp - 4) : sp - 4);
      hin[(size_t)ch * 64] = make_float2(hr, hi);
      const float nr = ar * hr - ai * hi + e[j].x, ni = ar * hi + ai * hr + e[j].y; hr = nr; hi = ni; }
  }
}

constexpr int UST = 4616;
constexpr int RST = 8200;
__device__ __forceinline__ void hyena_seq(CPR p, LAS unsigned char* lds, int l, int c, int which) {
  const int Ls = which ? CTXL : SEQL; const int rowbase = which ? MLAT : 0; const int ncg = Ls / 256;
  const bf16_t* hflt = (const bf16_t*)(p.ws + (which ? O_HFCTX : O_HFLAT));
  const float* hpart = (const float*)(p.ws + O_HPART + SM(l)) + (size_t)which * 256 * 1024;
  LAS float* red = (LAS float*)(lds + 4 * RST * 2 + 4 * UST * 2);
  const bf16_t* hyT = (const bf16_t*)(p.ws + O_HYT); bf16_t* yhyT = (bf16_t*)(p.ws + O_YHYT);
  LAS bf16_t* R0 = (LAS bf16_t*)lds; LAS bf16_t* U = R0 + 4 * RST;
  const int tid = ltid(), wid = tid >> 6, lane = tid & 63, n = lane & 31, hh = lane >> 5, q = n >> 2, b = n & 3;
  const int cg0 = 2 * wid; const bool act = cg0 < ncg; const bool has2 = (cg0 + 1) < ncg; const int T0 = cg0 * 256;
  float z1[2][16];
#pragma unroll
  for (int g2 = 0; g2 < 2; ++g2)
#pragma unroll
    for (int i = 0; i < 16; ++i) z1[g2][i] = 0.f;
  __syncthreads();
  {
    const int ntt = Ls / 16;
#pragma unroll
    for (int od = 0; od < 2; ++od) {
      float v = 0.f;
      if (tid < 2 * ntt) v = hpart[(size_t)(tid >> 1) * 1024 + od * 512 + (tid & 1) * 256 + c];
      v = wave_sum(v);
      if (lane == 0) red[od * 8 + wid] = v;
    }
    __syncthreads();
    if (tid < 2) { float s = 0.f; for (int w = 0; w < 8; ++w) s += red[tid * 8 + w]; red[16 + tid] = s; }
  }
#pragma unroll 1
  for (int order = 0; order < 2; ++order) {
    __syncthreads();
    const bf16_t* hf = hflt + ((size_t)(order * 2 + 0) * 256 + c) * Ls; const bf16_t* hb = hflt + ((size_t)(order * 2 + 1) * 256 + c) * Ls;
    for (int ci = tid; ci < Ls / 4; ci += NTHR) {
      const bool bw = ci >= Ls / 8; const int x0 = (bw ? ci - Ls / 8 : ci) * 8;
      const bf16x8 v = *(const bf16x8*)((bw ? hb : hf) + x0);
#pragma unroll
      for (int j = 0; j < 8; ++j) {
        const int x = x0 + j; const int i = bw ? Ls - 1 + x : Ls - 1 - x;
        if (!(bw && x == 0)) {
#pragma unroll
          for (int k = 0; k < 4; ++k) if (i - k >= 0) R0[k * RST + i - k] = (bf16_t)v[j];
        }
      }
    }
    if (order == 0) {
      const int nch = Ls / 8, npad = UST - Ls;
      for (int idx = tid; idx < 4 * nch; idx += NTHR) { const int bb = idx / nch, t8 = (idx % nch) * 8;
        *(LAS u32x4*)(U + bb * UST + 224 + t8) = *(const u32x4*)(hyT + (size_t)c * MT + rowbase + bb * Ls + t8); }
      for (int idx = tid; idx < 4 * npad; idx += NTHR) { const int bb = idx / npad, pp = idx % npad; U[bb * UST + (pp < 224 ? pp : pp + Ls)] = 0; }
    } else if (act) {
#pragma unroll
      for (int g2 = 0; g2 < 2; ++g2) if (g2 == 0 || has2)
#pragma unroll
        for (int i4 = 0; i4 < 4; ++i4) { const int t = T0 + g2 * 256 + 32 * q + 8 * i4 + 4 * hh;
          u32x2 o; o.x = cvt_pk_bf16(z1[g2][4 * i4], z1[g2][4 * i4 + 1]); o.y = cvt_pk_bf16(z1[g2][4 * i4 + 2], z1[g2][4 * i4 + 3]);
          *(LAS u32x2*)(U + b * UST + 224 + t) = o; }
    }
    __syncthreads();
    f32x16 acc0, acc1;
#pragma unroll
    for (int i = 0; i < 16; ++i) { acc0[i] = 0.f; acc1[i] = 0.f; }
    if (act) {
      const int e_lo = T0 - (Ls - 16), e_hi = (has2 ? T0 + 256 : T0) + 224;
      if (has2) {
        const bf16x8 z8 = {0, 0, 0, 0, 0, 0, 0, 0};
        bf16x8 r0 = z8, r1 = z8, r2 = z8, r3 = z8, r4 = z8, r5 = z8, r6 = z8, r7 = z8, r8 = z8, r9 = z8, r10 = z8, r11 = z8, r12 = z8, r13 = z8, r14 = z8, r15 = z8;
        const int o_lo = (Ls - 1) - e_lo - n + 8 * hh; const int kk = o_lo & 3;
        LAS const bf16_t* Rp = R0 + kk * RST + (o_lo - kk);
        LAS const bf16_t* Up = U + b * UST + 224 + (T0 + 32 * q - e_lo + 8 * hh);
#define HY_AF(j) const u32x2 a0 = *(LAS const u32x2*)(pa + 16 * (15 - (j))), a1 = *(LAS const u32x2*)(pa + 16 * (15 - (j)) + 4); u32x4 av; av.x = a0.x; av.y = a0.y; av.z = a1.x; av.w = a1.y; const bf16x8 af = __builtin_bit_cast(bf16x8, av);
#define HY_G0(j)   { HY_AF(j) const bf16x8 bf = *(LAS const bf16x8*)(pb + 16 * (15 - (j))); acc0 = MFMA32(af, bf, acc0); r##j = bf; }
#define HY_BOTH(j) { HY_AF(j) acc1 = MFMA32(af, r##j, acc1); const bf16x8 bf = *(LAS const bf16x8*)(pb + 16 * (15 - (j))); acc0 = MFMA32(af, bf, acc0); r##j = bf; }
#define HY_G1(j)   { HY_AF(j) acc1 = MFMA32(af, r##j, acc1); }
#define HY_SB __builtin_amdgcn_sched_barrier(0);
        { LAS const bf16_t* pa = Rp - 16 * 15; LAS const bf16_t* pb = Up - 16 * 15;
          HY_G0(0) HY_G0(1) HY_G0(2) HY_G0(3) HY_SB HY_G0(4) HY_G0(5) HY_G0(6) HY_G0(7) HY_SB HY_G0(8) HY_G0(9) HY_G0(10) HY_G0(11) HY_SB HY_G0(12) HY_G0(13) HY_G0(14) HY_G0(15) HY_SB }
        const int nb = Ls / 256 - 1;
#pragma unroll 1
        for (int blk = 1; blk <= nb; ++blk) {
          LAS const bf16_t* pa = Rp - 16 * (16 * blk + 15); LAS const bf16_t* pb = Up - 16 * (16 * blk + 15);
          HY_BOTH(0) HY_BOTH(1) HY_BOTH(2) HY_BOTH(3) HY_SB HY_BOTH(4) HY_BOTH(5) HY_BOTH(6) HY_BOTH(7) HY_SB HY_BOTH(8) HY_BOTH(9) HY_BOTH(10) HY_BOTH(11) HY_SB HY_BOTH(12) HY_BOTH(13) HY_BOTH(14) HY_BOTH(15) HY_SB
        }
        { LAS const bf16_t* pa = Rp - 16 * (16 * (nb + 1) + 15); LAS const bf16_t* pb = Up - 16 * (16 * (nb + 1) + 15);
          HY_BOTH(0) HY_BOTH(1) HY_BOTH(2) HY_BOTH(3) HY_SB HY_BOTH(4) HY_BOTH(5) HY_BOTH(6) HY_BOTH(7) HY_SB HY_BOTH(8) HY_BOTH(9) HY_BOTH(10) HY_BOTH(11) HY_SB HY_BOTH(12) HY_BOTH(13) HY_G1(14) HY_G1(15) HY_SB }
        { LAS const bf16_t* pa = Rp - 16 * (16 * (nb + 2) + 15);
          HY_G1(0) HY_G1(1) HY_G1(2) HY_G1(3) HY_SB HY_G1(4) HY_G1(5) HY_G1(6) HY_G1(7) HY_SB HY_G1(8) HY_G1(9) HY_G1(10) HY_G1(11) HY_SB HY_G1(12) HY_G1(13) HY_SB }
#undef HY_AF
#undef HY_G0
#undef HY_BOTH
#undef HY_G1
#undef HY_SB
      } else {
#pragma unroll 2
        for (int e = e_lo; e <= e_hi; e += 16) {
          const int o = (Ls - 1) - e - n + 8 * hh;
          const int kk = o & 3;
          LAS const u32x2* Rw = (LAS const u32x2*)(R0 + kk * RST + (o - kk));
          const u32x2 a0 = Rw[0], a1 = Rw[1];
          u32x4 av; av.x = a0.x; av.y = a0.y; av.z = a1.x; av.w = a1.y;
          const bf16x8 af = __builtin_bit_cast(bf16x8, av);
          const int s = T0 + 32 * q - e + 8 * hh; const bf16x8 bf = *(LAS const bf16x8*)(U + b * UST + 224 + s); acc0 = MFMA32(af, bf, acc0);
        }
      }
      const float scale = rsqrtf(red[16 + order] + EPS); const float bias = p.in[20][(size_t)l * 512 + order * 256 + c];
#pragma unroll
      for (int g2 = 0; g2 < 2; ++g2) if (g2 == 0 || has2) {
#pragma unroll
        for (int i4 = 0; i4 < 4; ++i4) {
          const int t = T0 + g2 * 256 + 32 * q + 8 * i4 + 4 * hh; const size_t row = (size_t)rowbase + b * Ls + t;
          const u32x2 gv = *(const u32x2*)(hyT + (size_t)((order + 1) * 256 + c) * MT + row);
          float gt[4] = {__uint_as_float(gv.x << 16), __uint_as_float(gv.x & 0xffff0000u), __uint_as_float(gv.y << 16), __uint_as_float(gv.y & 0xffff0000u)};
          float r[4];
          if (order == 0) {
            const u32x2 zv = *(LAS const u32x2*)(U + b * UST + 224 + t);
            float z0[4] = {__uint_as_float(zv.x << 16), __uint_as_float(zv.x & 0xffff0000u), __uint_as_float(zv.y << 16), __uint_as_float(zv.y & 0xffff0000u)};
#pragma unroll
            for (int j = 0; j < 4; ++j) { const float cv = (g2 ? acc1[4 * i4 + j] : acc0[4 * i4 + j]) * scale; r[j] = gt[j] * (cv + bias * z0[j]); z1[g2][4 * i4 + j] = r[j]; }
          } else {
#pragma unroll
            for (int j = 0; j < 4; ++j) { const float cv = (g2 ? acc1[4 * i4 + j] : acc0[4 * i4 + j]) * scale; r[j] = gt[j] * (cv + bias * z1[g2][4 * i4 + j]); }
            u32x2 o; o.x = cvt_pk_bf16(r[0], r[1]); o.y = cvt_pk_bf16(r[2], r[3]);
            *(u32x2*)(yhyT + (size_t)c * MT + row) = o;
          }
        }
      }
    }
  }
}

__device__ __forceinline__ void hytrans_item(CPR p, LAS unsigned char* lds, int it) {
  const int ch = it;
  const bf16_t* yhyT = (const bf16_t*)(p.ws + O_YHYT); bf16_t* ymix = (bf16_t*)(p.ws + O_ABUF);
  LAS bf16_t* T = (LAS bf16_t*)lds;
  const int tid = ltid();
  __syncthreads();
  { const int c = tid >> 3, t8 = (tid & 7) * 8;
    bf16x8 v[4];
#pragma unroll
    for (int s4 = 0; s4 < 4; ++s4) v[s4] = *(const bf16x8*)(yhyT + (size_t)(s4 * 64 + c) * MT + ch * 64 + t8);
#pragma unroll
    for (int s4 = 0; s4 < 4; ++s4)
#pragma unroll
      for (int j = 0; j < 8; ++j) T[(t8 + j) * 264 + s4 * 64 + c] = (bf16_t)v[s4][j]; }
  __syncthreads();
  { const int t = tid >> 3, c8 = (tid & 7) * 8;
#pragma unroll
    for (int s4 = 0; s4 < 4; ++s4) *(u32x4*)(ymix + (size_t)(ch * 64 + t) * 1024 + s4 * 64 + c8) = *(LAS const u32x4*)(T + t * 264 + s4 * 64 + c8); }
}

struct MlItem { int dir, b, h, sp, rb; };
__device__ __forceinline__ MlItem ml_decode(int it) {
  MlItem m; m.sp = it % 17; const int c = it / 17; m.h = c & 3; m.b = (c >> 2) & 3; m.dir = c >> 4;
  if (m.sp == 0) m.rb = MLAT + m.b * 256; else { const int bc = m.dir ? 16 - m.sp : m.sp - 1; m.rb = m.b * 4096 + bc * 256; }
  return m;
}
__device__ __forceinline__ void ml_gate_scan(CPR p, int l, const MlItem& m, LAS float* bcsA, LAS float* colvA, LAS float* pmaxA, LAS float* tmp) {
  const int tid = ltid(), wid = tid >> 6, lane = tid & 63;
  float v = 0.f, ir = 0.f;
  if (tid < 256) {
    const int row = m.rb + (m.dir ? 255 - tid : tid);
    const float* pg = (const float*)(p.ws + O_PG) + (size_t)row * 16;
    const float* gb = p.in[34] + (size_t)l * 16;
    ir = pg[m.dir * 8 + m.h] + gb[(m.dir * 2) * 4 + m.h];
    const float fr = pg[m.dir * 8 + 4 + m.h] + gb[(m.dir * 2 + 1) * 4 + m.h];
    v = fminf(fr, 0.f) - log1pf(expf(-fabsf(fr)));
#pragma unroll
    for (int o = 1; o < 64; o <<= 1) { const float t = __shfl_up(v, o); if (lane >= o) v += t; }
    if (lane == 63) tmp[wid] = v;
  }
  __syncthreads();
  float cv = 0.f;
  if (tid < 256) {
    float pre = 0.f; for (int w = 0; w < wid; ++w) pre += tmp[w];
    v += pre; cv = ir - v;
    float pm = cv;
#pragma unroll
    for (int o = 1; o < 64; o <<= 1) { const float t = __shfl_up(pm, o); if (lane >= o) pm = fmaxf(pm, t); }
    if (lane == 63) tmp[8 + wid] = pm;
    bcsA[tid] = v; colvA[tid] = cv; pmaxA[tid] = pm;
  }
  __syncthreads();
  if (tid < 256) { float pm = pmaxA[tid]; for (int w = 0; w < wid; ++w) pm = fmaxf(pm, tmp[8 + w]); pmaxA[tid] = pm; }
  __syncthreads();
}

__device__ __forceinline__ void ml_cloc_item(CPR p, LAS unsigned char* lds, int l, int it) {
  const MlItem m = ml_decode(it);
  const bf16_t* P = (const bf16_t*)(p.ws + O_P); const bf16_t* kb = (const bf16_t*)(p.ws + O_K);
  LAS bf16_t* VW = (LAS bf16_t*)lds;
  LAS bf16_t* KT = VW + 144 * 136;
  LAS float* bcsA = (LAS float*)(KT + 128 * 136); LAS float* colvA = bcsA + 256; LAS float* pmaxA = colvA + 256; LAS float* wA = pmaxA + 256; LAS float* tmp = wA + 256;
  const int tid = ltid(), wid = tid >> 6, lane = tid & 63, cl = lane & 15, quad = lane >> 4;
  __syncthreads();
  ml_gate_scan(p, l, m, bcsA, colvA, pmaxA, tmp);
  const float maxcv = pmaxA[255], gtot = bcsA[255];
  if (tid < 256) wA[tid] = __expf(colvA[tid] - maxcv);
  for (int i = tid; i < 15 * 136; i += NTHR) VW[129 * 136 + i] = 0;
  f32x4 acc[9];
#pragma unroll
  for (int r = 0; r < 9; ++r) acc[r] = (f32x4){0.f, 0.f, 0.f, 0.f};
#pragma unroll 1
  for (int half = 0; half < 2; ++half) {
    __syncthreads();
    {
      const int tl = tid & 127, db = (tid >> 7) * 32; const int tau = half * 128 + tl;   const int row = m.rb + (m.dir ? 255 - tau : tau);
      const float w = wA[tau];
      const bf16_t* vs = P + (size_t)row * PW + 1536 + m.h * 128 + db; const bf16_t* ks = kb + (size_t)row * 512 + m.h * 128 + db;
#pragma unroll
      for (int g4 = 0; g4 < 4; ++g4) {
        const bf16x8 vv = *(const bf16x8*)(vs + g4 * 8), kv = *(const bf16x8*)(ks + g4 * 8);
#pragma unroll
        for (int j = 0; j < 8; ++j) { VW[(db + g4 * 8 + j) * 136 + tl] = f2bf(bf2f((bf16_t)vv[j]) * w); KT[(db + g4 * 8 + j) * 136 + tl] = (bf16_t)kv[j]; }
      }
      if (tid < 128) VW[128 * 136 + tl] = f2bf(w);
    }
    __syncthreads();
#pragma unroll
    for (int ks = 0; ks < 4; ++ks) {
      const bf16x8 bf = *(LAS const bf16x8*)(KT + (16 * wid + cl) * 136 + 32 * ks + 8 * quad);
#pragma unroll
      for (int r = 0; r < 9; ++r) { const bf16x8 af = *(LAS const bf16x8*)(VW + (16 * r + cl) * 136 + 32 * ks + 8 * quad); acc[r] = MFMA16(af, bf, acc[r]); }
    }
  }
  float* cst = (float*)(p.ws + O_CST) + (size_t)it * 129 * 128;
#pragma unroll
  for (int r = 0; r < 9; ++r)
#pragma unroll
    for (int i = 0; i < 4; ++i) { const int d = 16 * r + quad * 4 + i; if (d < 129) cst[(size_t)d * 128 + 16 * wid + cl] = acc[r][i]; }
  if (tid == 0) { float* sc = (float*)(p.ws + O_SC + SM(l)); sc[it * 32] = gtot + maxcv; sc[it * 32 + 1] = gtot; }
}

__device__ __forceinline__ void ml_carry(CPR p, int l) {
  float* cst = (float*)(p.ws + O_CST); const float* sc = (const float*)(p.ws + O_SC + SM(l)); float* mprev = (float*)(p.ws + O_SC + SM(l)) + 544 * 32;
  const int total = 32 * 129 * 128;
  for (int idx = blockIdx.x * NTHR + ltid(); idx < total; idx += gridDim.x * NTHR) {
    const int chain = idx / (129 * 128), el = idx % (129 * 128);
    float cj[17], mj[17], gj[17];
#pragma unroll
    for (int sp = 0; sp < 17; ++sp) { const int it = chain * 17 + sp; cj[sp] = cst[(size_t)it * 129 * 128 + el]; mj[sp] = sc[it * 32]; gj[sp] = sc[it * 32 + 1]; }
    float mst = 0.f, val = 0.f;
#pragma unroll
    for (int sp = 0; sp < 17; ++sp) {
      const int it = chain * 17 + sp;
      cst[(size_t)it * 129 * 128 + el] = val; if (el == 0) mprev[it * 32] = mst;
      const float mnew = fmaxf(gj[sp] + mst, mj[sp]);
      val = __expf(gj[sp] + mst - mnew) * val + __expf(mj[sp] - mnew) * cj[sp]; mst = mnew;
    }
  }
}
__device__ __forceinline__ void ml_out_item(CPR p, LAS unsigned char* lds, int l, int it, int half) {
  const MlItem m = ml_decode(it);
  const bf16_t* P = (const bf16_t*)(p.ws + O_P); const bf16_t* qb = (const bf16_t*)(p.ws + O_Q); const bf16_t* kb = (const bf16_t*)(p.ws + O_K);
  bf16_t* hd = (bf16_t*)(p.ws + O_HDIR) + (size_t)m.dir * MT * 512;
  LAS bf16_t* Qs = (LAS bf16_t*)lds;
  LAS bf16_t* Ks = Qs + 64 * 136;
  LAS bf16_t* VT = Ks + 64 * 136;
  LAS bf16_t* Ss = VT + 144 * 72;
  LAS bf16_t* CP = Ss + 64 * 72;
  LAS float* bcsA = (LAS float*)(CP + 144 * 136); LAS float* colvA = bcsA + 256; LAS float* pmaxA = colvA + 256; LAS float* MA = pmaxA + 256; LAS float* nqs = MA + 256; LAS float* tmp = nqs + 64;
  const int tid = ltid(), wid = tid >> 6, lane = tid & 63, cl = lane & 15, quad = lane >> 4;
  __syncthreads();
  ml_gate_scan(p, l, m, bcsA, colvA, pmaxA, tmp);
  const float mprev = ((const float*)(p.ws + O_SC + SM(l)))[(544 + it) * 32];
  if (tid < 256) MA[tid] = fmaxf(pmaxA[tid], mprev);
  {
    const float* cst = (const float*)(p.ws + O_CST) + (size_t)it * 129 * 128;
    for (int i = tid; i < 144 * 32; i += NTHR) { const int d = i >> 5, e4 = (i & 31) * 4; u32x2 o; o.x = 0; o.y = 0;
      if (d < 129) { const float4 v = *(const float4*)(cst + (size_t)d * 128 + e4); o.x = cvt_pk_bf16(v.x, v.y); o.y = cvt_pk_bf16(v.z, v.w); }
      *(LAS u32x2*)(CP + d * 136 + e4) = o; }
  }
  const int rt = wid >> 1; const int ct0 = (wid & 1) ? 5 : 0; const int nct = (wid & 1) ? 4 : 5;
#pragma unroll 1
  for (int qi = 0; qi < 2; ++qi) {
    const int qt = half ? 1 + qi : 3 * qi;
    __syncthreads();
    for (int i = tid; i < 64 * 16; i += NTHR) { const int r = i >> 4, c8 = (i & 15) * 8; const int tau = 64 * qt + r; const int row = m.rb + (m.dir ? 255 - tau : tau);
      *(LAS u32x4*)(Qs + r * 136 + c8) = *(const u32x4*)(qb + (size_t)row * 512 + m.h * 128 + c8); }
    u32x4 kreg[2]; bf16x8 vreg[2];
#pragma unroll
    for (int u = 0; u < 2; ++u) { const int i = tid + u * NTHR; const int r = i >> 4, c8 = (i & 15) * 8; const int row = m.rb + (m.dir ? 255 - r : r);
      const int rv = i & 63, cv = (i >> 6) * 8; const int rowv = m.rb + (m.dir ? 255 - rv : rv);
      kreg[u] = *(const u32x4*)(kb + (size_t)row * 512 + m.h * 128 + c8); vreg[u] = *(const bf16x8*)(P + (size_t)rowv * PW + 1536 + m.h * 128 + cv); }
    f32x4 acc[5];
#pragma unroll
    for (int t = 0; t < 5; ++t) acc[t] = (f32x4){0.f, 0.f, 0.f, 0.f};
#pragma unroll 1
    for (int kt = 0; kt <= qt; ++kt) {
      __syncthreads();
#pragma unroll
      for (int u = 0; u < 2; ++u) { const int i = tid + u * NTHR; const int r = i >> 4, c8 = (i & 15) * 8; const int rv = i & 63, cv = (i >> 6) * 8;
        *(LAS u32x4*)(Ks + r * 136 + c8) = kreg[u];
#pragma unroll
        for (int j = 0; j < 8; ++j) VT[(cv + j) * 72 + rv] = (bf16_t)vreg[u][j]; }
      if (kt < qt) {
#pragma unroll
        for (int u = 0; u < 2; ++u) { const int i = tid + u * NTHR; const int r = i >> 4, c8 = (i & 15) * 8; const int sg = 64 * (kt + 1) + r; const int row = m.rb + (m.dir ? 255 - sg : sg);
          const int rv = i & 63, cv = (i >> 6) * 8; const int sgv = 64 * (kt + 1) + rv; const int rowv = m.rb + (m.dir ? 255 - sgv : sgv);
          kreg[u] = *(const u32x4*)(kb + (size_t)row * 512 + m.h * 128 + c8); vreg[u] = *(const bf16x8*)(P + (size_t)rowv * PW + 1536 + m.h * 128 + cv); }
      }
      for (int i = tid; i < 16 * 64; i += NTHR) { const int d = 128 + (i >> 6), r = i & 63; VT[d * 72 + r] = (d == 128) ? (bf16_t)0x3f80 : (bf16_t)0; }
      __syncthreads();
#pragma unroll
      for (int c2 = 0; c2 < 2; ++c2) {
        const int ct = (wid & 1) * 2 + c2;
        f32x4 s = {0.f, 0.f, 0.f, 0.f};
#pragma unroll
        for (int ks = 0; ks < 4; ++ks) { const bf16x8 a = *(LAS const bf16x8*)(Qs + (16 * rt + cl) * 136 + 32 * ks + 8 * quad); const bf16x8 b = *(LAS const bf16x8*)(Ks + (16 * ct + cl) * 136 + 32 * ks + 8 * quad); s = MFMA16(a, b, s); }
        const int sg = 64 * kt + 16 * ct + cl; const float cvs = colvA[sg];
#pragma unroll
        for (int i = 0; i < 4; ++i) { const int tl = 16 * rt + quad * 4 + i; const int tau = 64 * qt + tl;
          const float v = (sg <= tau) ? s[i] * __expf(cvs - MA[tau]) : 0.f;
          Ss[tl * 72 + 16 * ct + cl] = f2bf(v); }
      }
      __syncthreads();
#pragma unroll
      for (int ks = 0; ks < 2; ++ks) {
        const bf16x8 a = *(LAS const bf16x8*)(Ss + (16 * rt + cl) * 72 + 32 * ks + 8 * quad);
#pragma unroll
        for (int t = 0; t < 5; ++t) { const int ctt = (ct0 + t) < 8 ? (ct0 + t) : 8;
          const bf16x8 b = *(LAS const bf16x8*)(VT + (16 * ctt + cl) * 72 + 32 * ks + 8 * quad); acc[t] = MFMA16(a, b, acc[t]); }
      }
    }
    {
      f32x4 ta[5];
#pragma unroll
      for (int t = 0; t < 5; ++t) ta[t] = (f32x4){0.f, 0.f, 0.f, 0.f};
#pragma unroll
      for (int ks = 0; ks < 4; ++ks) {
        const bf16x8 a = *(LAS const bf16x8*)(Qs + (16 * rt + cl) * 136 + 32 * ks + 8 * quad);
#pragma unroll
        for (int t = 0; t < 5; ++t) { const int ctt = (ct0 + t) < 8 ? (ct0 + t) : 8;
          const bf16x8 b = *(LAS const bf16x8*)(CP + (16 * ctt + cl) * 136 + 32 * ks + 8 * quad); ta[t] = MFMA16(a, b, ta[t]); }
      }
#pragma unroll
      for (int i = 0; i < 4; ++i) { const int tau = 64 * qt + 16 * rt + quad * 4 + i; const float wi = __expf(mprev - MA[tau]);
#pragma unroll
        for (int t = 0; t < 5; ++t) acc[t][i] += wi * ta[t][i]; }
    }
    if ((wid & 1) && cl == 0) {
#pragma unroll
      for (int i = 0; i < 4; ++i) nqs[16 * rt + quad * 4 + i] = acc[3][i];
    }
    __syncthreads();
#pragma unroll
    for (int i = 0; i < 4; ++i) {
      const int tl = 16 * rt + quad * 4 + i; const int tau = 64 * qt + tl; const int row = m.rb + (m.dir ? 255 - tau : tau);
      const float den = 1.f / fmaxf(fabsf(nqs[tl]), __expf(-(bcsA[tau] + MA[tau])));
#pragma unroll
      for (int t = 0; t < 5; ++t) { const int ct = ct0 + t; if (t < nct && ct < 8) hd[(size_t)row * 512 + m.h * 128 + 16 * ct + cl] = f2bf(acc[t][i] * den); }
    }
  }
}

__device__ __forceinline__ void ml_combine_row(CPR p, int l, int row) {
  const int lane = ltid() & 63; const int c8 = lane * 8;
  const bf16_t* P = (const bf16_t*)(p.ws + O_P); const bf16_t* hd = (const bf16_t*)(p.ws + O_HDIR); const bf16_t* xcb = (const bf16_t*)(p.ws + O_XC);
  bf16_t* ymix = (bf16_t*)(p.ws + O_ABUF);
  const bf16x8 hf = *(const bf16x8*)(hd + (size_t)row * 512 + c8), hb = *(const bf16x8*)(hd + ((size_t)MT + row) * 512 + c8);
  const bf16x8 xo = *(const bf16x8*)(P + (size_t)row * PW + 2048 + c8), xc = *(const bf16x8*)(xcb + (size_t)row * 512 + c8);
  float h[8]; float ss = 0.f;
#pragma unroll
  for (int j = 0; j < 8; ++j) { h[j] = bf2f((bf16_t)hf[j]) + bf2f((bf16_t)hb[j]); ss += h[j] * h[j]; }
#pragma unroll
  for (int o = 1; o < 16; o <<= 1) ss += __shfl_xor(ss, o);
  const float r = rsqrtf(ss * (1.f / 128.f) + EPS);
  const float* gain = p.in[36] + (size_t)l * 512 + c8; const float* skip = p.in[35] + (size_t)l * 512 + c8;
  float o[8];
#pragma unroll
  for (int j = 0; j < 8; ++j) o[j] = sigmoidf_(bf2f((bf16_t)xo[j])) * (h[j] * r * gain[j] + skip[j] * bf2f((bf16_t)xc[j]));
  u32x4 ov; ov.x = cvt_pk_bf16(o[0], o[1]); ov.y = cvt_pk_bf16(o[2], o[3]); ov.z = cvt_pk_bf16(o[4], o[5]); ov.w = cvt_pk_bf16(o[6], o[7]);
  *(u32x4*)(ymix + (size_t)row * 1024 + 512 + c8) = ov;
}

__device__ __forceinline__ void s5_glu_item(CPR p, LAS unsigned char* lds, int l, int it) {
  const bf16_t* P = (const bf16_t*)(p.ws + O_P); const float* Yd = (const float*)(p.ws + O_YDIR); bf16_t* ymix = (bf16_t*)(p.ws + O_ABUF);
  const bf16_t* wg = (const bf16_t*)(p.ws + O_WGLUT + SM(l));
  LAS bf16_t* G = (LAS bf16_t*)lds;
  const int tid = ltid(), wid = tid >> 6, lane = tid & 63, cl = lane & 15, quad = lane >> 4;
  __syncthreads();
  for (int i = tid; i < 64 * 64; i += NTHR) {
    const int r = i >> 6, c4 = (i & 63) * 4; const size_t row = (size_t)it * 64 + r;
    const int gg = c4 >> 4, cc = c4 & 15;
    const float4 yf = *(const float4*)(Yd + ((size_t)gg * MT + row) * 16 + cc), yb = *(const float4*)(Yd + ((size_t)(16 + gg) * MT + row) * 16 + cc);
    const u32x2 uv = *(const u32x2*)(P + row * PW + 768 + c4);
    const float4 dd = *(const float4*)(p.in[28] + (size_t)l * 256 + c4);
    float y[4] = {yf.x + yb.x + dd.x * __uint_as_float(uv.x << 16), yf.y + yb.y + dd.y * __uint_as_float(uv.x & 0xffff0000u),
                  yf.z + yb.z + dd.z * __uint_as_float(uv.y << 16), yf.w + yb.w + dd.w * __uint_as_float(uv.y & 0xffff0000u)};
#pragma unroll
    for (int j = 0; j < 4; ++j) { const float x = y[j]; y[j] = 0.5f * x * (1.f + tanhf(0.7978845608028654f * (x + 0.044715f * x * x * x))); }
    u32x2 o; o.x = cvt_pk_bf16(y[0], y[1]); o.y = cvt_pk_bf16(y[2], y[3]);
    *(LAS u32x2*)(G + r * 264 + c4) = o;
  }
  __syncthreads();
  f32x4 acc[2][4];
#pragma unroll
  for (int a = 0; a < 2; ++a)
#pragma unroll
    for (int b = 0; b < 4; ++b) acc[a][b] = (f32x4){0.f, 0.f, 0.f, 0.f};
#pragma unroll 2
  for (int kk = 0; kk < 8; ++kk) {
    bf16x8 bf[2], af[4];
#pragma unroll
    for (int c2 = 0; c2 < 2; ++c2) bf[c2] = *(const bf16x8*)(wg + (size_t)(16 * (2 * wid + c2) + cl) * 256 + 32 * kk + 8 * quad);
#pragma unroll
    for (int r4 = 0; r4 < 4; ++r4) af[r4] = *(LAS const bf16x8*)(G + (16 * r4 + cl) * 264 + 32 * kk + 8 * quad);
#pragma unroll
    for (int c2 = 0; c2 < 2; ++c2)
#pragma unroll
      for (int r4 = 0; r4 < 4; ++r4) acc[c2][r4] = MFMA16(af[r4], bf[c2], acc[c2][r4]);
  }
#pragma unroll
  for (int c2 = 0; c2 < 2; ++c2) {
    const int n = 16 * (2 * wid + c2) + cl; const float bg = p.in[30][(size_t)l * 256 + n];
#pragma unroll
    for (int r4 = 0; r4 < 4; ++r4)
#pragma unroll
      for (int i = 0; i < 4; ++i) { const int r = 16 * r4 + quad * 4 + i; const float g = bf2f(G[r * 264 + n]);
        ymix[((size_t)it * 64 + r) * 1024 + 256 + n] = f2bf(g * sigmoidf_(acc[c2][r4][i] + bg)); }
  }
}
#define XB_TMO      128
#define XB_XCNT(j)  (256  + 64 * (j))
#define XB_XSUB(j)  (1280 + 64 * (j))
#define XB_XGEN(j)  (2304 + 64 * (j))
#define XB_TOP      3328
#define XB_TOPGEN   3392
#define XCD_BAR_WORDS 3456
#define XB_SPIN_CAP (1u << 18)

__device__ __forceinline__ unsigned xb_ld(unsigned* p)              { return __hip_atomic_load(p, __ATOMIC_RELAXED, __HIP_MEMORY_SCOPE_AGENT); }
__device__ __forceinline__ unsigned xb_add(unsigned* p, unsigned v) { return __hip_atomic_fetch_add(p, v, __ATOMIC_RELAXED, __HIP_MEMORY_SCOPE_AGENT); }
__device__ __forceinline__ unsigned xb_xcc_id() { return (unsigned)__builtin_amdgcn_s_getreg((3 << 11) | 20) & 0xFu; }
#define XB_SPIN(cond, bar) do { unsigned _sp = 0; while (cond) { __builtin_amdgcn_s_sleep(1); \
    if ((++_sp & 255u) == 0u) { if (xb_ld(&(bar)[XB_TMO])) break; if (_sp > XB_SPIN_CAP) { atomicAdd(&(bar)[XB_TMO], 1u); break; } } } } while (0)

struct XcdBarrier {
    unsigned* bar; unsigned x;
    volatile LAS unsigned* st;
};

__device__ __forceinline__ XcdBarrier xcd_barrier_post(unsigned* bar, volatile LAS unsigned* st) {
    XcdBarrier b; b.bar = bar; b.x = xb_xcc_id(); b.st = st;
    if (threadIdx.x == 0) (void)xb_add(&bar[XB_XCNT(b.x)], 1u);
    return b;
}
__device__ __forceinline__ void xcd_barrier_complete(unsigned* bar, unsigned x, unsigned& nloc, unsigned& nx) {
    const unsigned G = gridDim.x * gridDim.y * gridDim.z;
    unsigned sum, cnt, mine, sp = 0u;
    for (;;) {
        sum = 0u; cnt = 0u; mine = 0u;
#pragma unroll
        for (unsigned j = 0; j < 16; ++j) { const unsigned c = xb_ld(&bar[XB_XCNT(j)]); sum += c; cnt += (c > 0u) ? 1u : 0u; mine = (j == x) ? c : mine; }
        if (sum == G) break;
        __builtin_amdgcn_s_sleep(1);
        if ((++sp & 255u) == 0u) { if (xb_ld(&bar[XB_TMO])) break; if (sp > XB_SPIN_CAP) { atomicAdd(&bar[XB_TMO], 1u); break; } }
    }
    nloc = mine > 0u ? mine : 1u; nx = cnt > 0u ? cnt : 1u;
}

__device__ __forceinline__ void xcd_barrier(const XcdBarrier& b) {
    asm volatile("s_waitcnt vmcnt(0)" ::: "memory");
    __syncthreads();
    if (threadIdx.x == 0) {
        unsigned* bar = b.bar;
        __builtin_amdgcn_s_waitcnt(0);
        unsigned nloc = b.st[0], nx = b.st[1];
        if (nloc == 0u) { xcd_barrier_complete(bar, b.x, nloc, nx); b.st[0] = nloc; b.st[1] = nx; }
        const unsigned old = xb_add(&bar[XB_XSUB(b.x)], 1u);
        const unsigned gen = old / nloc;
        if (old + 1u == (gen + 1u) * nloc) {
            __builtin_amdgcn_fence(__ATOMIC_RELEASE, "agent");
            asm volatile("s_waitcnt vmcnt(0)" ::: "memory");
            const unsigned og = xb_add(&bar[XB_TOP], 1u);
            const unsigned tg = og / nx;
            if (og + 1u == (tg + 1u) * nx) xb_add(&bar[XB_TOPGEN], 1u);
            else XB_SPIN(xb_ld(&bar[XB_TOPGEN]) == tg, bar);
            __builtin_amdgcn_fence(__ATOMIC_ACQUIRE, "agent");
            xb_add(&bar[XB_XGEN(b.x)], 1u);
            asm volatile("s_waitcnt vmcnt(0)" ::: "memory");
        } else {
            XB_SPIN(xb_ld(&bar[XB_XGEN(b.x)]) == gen, bar);
            __builtin_amdgcn_fence(__ATOMIC_ACQUIRE, "agent");
            asm volatile("s_waitcnt vmcnt(0)" ::: "memory");
        }
    }
    __syncthreads();
}

#define GSYNC() xcd_barrier(xb)
#define RUN_ITEMS(N, CALL) do { for (int it = first_item(off, G); it < (N); it += G) { CALL; } off = (off + (N)) % G; } while (0)

__global__ void __launch_bounds__(NTHR, 2) fwd_megakernel(Params p_arg) {
  CPR p = *(const __attribute__((address_space(4))) Params*)__builtin_amdgcn_kernarg_segment_ptr();
  extern __shared__ __attribute__((aligned(16))) unsigned char lds_raw[];
  LAS unsigned char* lds = (LAS unsigned char*)lds_raw;
  cg::grid_group grid = cg::this_grid();
  const int G = gridDim.x;
  const int wid = ltid() >> 6;
  unsigned char* ws = p.ws;
  float* modt = (float*)(ws + O_MOD);
  float* ctxcur = (float*)(ws + O_CTX);
  float* Ybuf = (float*)(ws + O_P);
  bf16_t* ABUF = (bf16_t*)(ws + O_ABUF);

  volatile LAS unsigned* xbst = (volatile LAS unsigned*)(lds + LDS_BYTES - 16);
  if (ltid() == 0) { xbst[0] = 0u; xbst[1] = 0u; xbst[2] = 0u; xbst[3] = 0u; }
  __syncthreads();
  const XcdBarrier xb = xcd_barrier_post((unsigned*)ws, xbst);
#ifndef PH_MASK
#define PH_MASK 0xffffffff
#endif
#define PH(n) if (PH_MASK & (1u << (n)))
  PH(0) phase_mod(p, lds);
  if (p_arg.ws == nullptr) grid.sync();
  GSYNC();

#pragma unroll 1
  for (int l = 0; l < DEPTH; ++l) {
    int off = 0;
    const int Mg = (l < DEPTH - 1) ? MT : MLAT;
    {
      RowCfg rc;
      rc.srcL = l == 0 ? p.in[0] : p.out; rc.srcC = l == 0 ? p.in[2] : ctxcur; rc.dstL = p.out; rc.dstC = ctxcur;
      rc.Y = l > 0 ? Ybuf : nullptr; rc.ypart = l > 0 ? Ybuf + (size_t)MT * 1024 : nullptr; rc.gpost = p.in[9] + (size_t)(l > 0 ? l - 1 : 0) * 1024; rc.modA = modt + (size_t)(l > 0 ? l - 1 : 0) * 5 * 6144; rc.gate_off = 5120;
      rc.gpre = p.in[6] + (size_t)l * 1024; rc.modB = modt + (size_t)l * 5 * 6144; rc.sc_off = 1024; rc.sh_off = 0; rc.abuf = ABUF;
      PH(1) RUN_ITEMS(NCONV, conv_item(p, lds, l, it));
      PH(2) RUN_ITEMS(272, hyfilt_item(p, lds, l, it));
      PH(3) RUN_ITEMS(4, s5tab_item(p, l, it));
      PH(4) RUN_ITEMS(MT / 8, row_item(rc, it * 8 + wid));
    }
    GSYNC();
    {
      pg8::Gemm g{ABUF, (const bf16_t*)(ws + O_WINT), MT, PWP, 1024, 1024};
      pg8::StaticOrder S; S.init(g.M, g.N, G, blockIdx.x);
      pg8::EpiP E{(bf16_t*)(ws + O_P), (float*)(ws + O_PG)};
      PH(5) pg8::gemm_phase(lds, g, S, E);
    }
    GSYNC();
    off = 0;
    PH(6) RUN_ITEMS(1088, mlqk_item(p, lds, l, it));
    __syncthreads();
    __syncthreads();
    PH(7) RUN_ITEMS(1088, s5_chunk<true>(p, lds + wid * 12800, it * 8 + wid, l, true));
    PH(8) RUN_ITEMS(816, hyshort_item(p, lds, l, it));
    GSYNC();
    off = 0;
    PH(9) RUN_ITEMS(256, { hyena_seq(p, lds, l, it, 0); if (l < DEPTH - 1) hyena_seq(p, lds, l, it, 1); });
    PH(10) RUN_ITEMS(544, ml_cloc_item(p, lds, l, it));
    PH(11) RUN_ITEMS(16, s5_carry_item(p, it, l));
    GSYNC();
    off = 0;
    PH(12) ml_carry(p, l);
    __syncthreads();
    PH(13) RUN_ITEMS(1088, s5_chunk<true>(p, lds + wid * 12800, it * 8 + wid, l, false));
    PH(14) RUN_ITEMS(Mg / 64, hytrans_item(p, lds, it));
    GSYNC();
    off = 0;
    PH(15) RUN_ITEMS(l < DEPTH - 1 ? 1088 : 1024, ml_out_item(p, lds, l, l < DEPTH - 1 ? (it >> 1) : ((it >> 5) * 17 + 1 + ((it >> 1) & 15)), it & 1));
    PH(16) RUN_ITEMS(Mg / 64, s5_glu_item(p, lds, l, it));
    GSYNC();
    off = 0;
    PH(17) RUN_ITEMS(Mg / 8, ml_combine_row(p, l, it * 8 + wid));
#ifdef DBG_ZERO
    { bf16_t* ym = (bf16_t*)(ws + O_ABUF);
      for (int i = blockIdx.x * NTHR + ltid(); i < MT * 128; i += G * NTHR) { const int row = i >> 7, c8 = (i & 127) * 8; const u32x4 z = {0u, 0u, 0u, 0u};
        if (c8 >= 512 ? !(PH_MASK & (1u << 17)) : (c8 >= 256 ? !(PH_MASK & (1u << 16)) : !(PH_MASK & (1u << 14)))) *(u32x4*)(ym + (size_t)row * 1024 + c8) = z; } }
#endif
    GSYNC();
    {
      pg8::Gemm g{ABUF, (const bf16_t*)(ws + O_WOUTT), MLAT, 1024, 1024, 1024};
      pg8::StaticOrder S; S.init(g.M, g.N, G, blockIdx.x);
      pg8::EpiF32 E{Ybuf};
      PH(18) pg8::gemm_phase(lds, g, S, E);
      if (l < DEPTH - 1) {
        pg8::Gemm g2{ABUF, (const bf16_t*)(ws + O_WOUTT), MT, 1024, 256, 1024};
        pg8::CtxSplitOrder S2; S2.init(G, blockIdx.x);
        pg8::EpiF32Split E2{Ybuf, Ybuf + (size_t)MT * 1024};
        PH(18) pg8::gemm_phase(lds, g2, S2, E2);
      }
    }
    GSYNC();
    {
      RowCfg rc;
      rc.srcL = p.out; rc.srcC = ctxcur; rc.dstL = p.out; rc.dstC = ctxcur;
      rc.Y = Ybuf; rc.ypart = (l < DEPTH - 1) ? Ybuf + (size_t)MT * 1024 : nullptr; rc.gpost = p.in[7] + (size_t)l * 1024; rc.modA = modt + (size_t)l * 5 * 6144; rc.gate_off = 2048;
      rc.gpre = p.in[8] + (size_t)l * 1024; rc.modB = rc.modA; rc.sc_off = 4096; rc.sh_off = 3072; rc.abuf = ABUF;
      off = 0;
      PH(19) RUN_ITEMS(Mg / 8, row_item(rc, it * 8 + wid));
    }
    GSYNC();
    {
      pg8::Gemm g{ABUF, (const bf16_t*)(ws + O_W1T), Mg, 4096, 1024, 1024};
      pg8::StaticOrder S; S.init(g.M, g.N, G, blockIdx.x);
      pg8::EpiRelu2 E{(bf16_t*)(ws + O_MIX)};
      PH(20) pg8::gemm_phase(lds, g, S, E);
    }
    GSYNC();
    {
      pg8::Gemm g{(const bf16_t*)(ws + O_MIX), (const bf16_t*)(ws + O_W2T), MLAT, 1024, 4096, 4096};
      pg8::StaticOrder S; S.init(g.M, g.N, G, blockIdx.x);
      pg8::EpiF32 E{Ybuf};
      PH(21) pg8::gemm_phase(lds, g, S, E);
      if (l < DEPTH - 1) {
        pg8::Gemm g2{(const bf16_t*)(ws + O_MIX), (const bf16_t*)(ws + O_W2T), MT, 1024, 1024, 4096};
        pg8::CtxSplitOrder S2; S2.init(G, blockIdx.x);
        pg8::EpiF32Split E2{Ybuf, Ybuf + (size_t)MT * 1024};
        PH(21) pg8::gemm_phase(lds, g2, S2, E2);
      }
    }
    GSYNC();
  }
  {
    RowCfg rc;
    rc.srcL = p.out; rc.srcC = ctxcur; rc.dstL = p.out; rc.dstC = ctxcur;
    rc.Y = Ybuf; rc.ypart = nullptr; rc.gpost = p.in[9] + (size_t)(DEPTH - 1) * 1024; rc.modA = modt + (size_t)(DEPTH - 1) * 5 * 6144; rc.gate_off = 5120;
    rc.gpre = nullptr; rc.modB = rc.modA; rc.sc_off = 0; rc.sh_off = 0; rc.abuf = ABUF;
    int off = 0;
    PH(22) RUN_ITEMS(MLAT / 8, row_item(rc, it * 8 + wid));
  }
}

extern "C" void kernel_launch(void* const* d_in, const int* in_sizes, int n_in, void* d_out, int out_size, void* d_ws, size_t ws_size, hipStream_t stream) {
  static int grid_blocks = 0;
  if (grid_blocks == 0) {
    if (n_in != 39 || ws_size < WS_NEED) { fprintf(stderr, "kernel_launch: need 39 inputs and %zu bytes of workspace; got %d, %zu\n", (size_t)WS_NEED, n_in, ws_size); grid_blocks = -1; return; }
    int dev = 0, cus = 0, per_cu = 0;
    hipGetDevice(&dev);
    hipDeviceGetAttribute(&cus, hipDeviceAttributeMultiprocessorCount, dev);
    if (hipFuncSetAttribute((const void*)fwd_megakernel, hipFuncAttributeMaxDynamicSharedMemorySize, LDS_BYTES) != hipSuccess) { fprintf(stderr, "kernel_launch: hipFuncSetAttribute failed\n"); grid_blocks = -1; return; }
    if (hipOccupancyMaxActiveBlocksPerMultiprocessor(&per_cu, (const void*)fwd_megakernel, NTHR, LDS_BYTES) != hipSuccess || per_cu < 1) { fprintf(stderr, "kernel_launch: occupancy query gave %d\n", per_cu); per_cu = 1; }
    (void)hipGetLastError();
    grid_blocks = cus;
  }
  if (grid_blocks < 0) return;
  if (hipMemsetAsync(d_ws, 0, XCD_BAR_WORDS * sizeof(unsigned), stream) != hipSuccess) { fprintf(stderr, "kernel_launch: memset of the barrier words failed\n"); return; }
  Params p{};
  for (int i = 0; i < 39; ++i) p.in[i] = (const float*)d_in[i];
  p.out = (float*)d_out; p.ws = (unsigned char*)d_ws;
  void* args[] = {&p};
  hipError_t e = hipLaunchCooperativeKernel((const void*)fwd_megakernel, dim3(grid_blocks), dim3(NTHR), args, LDS_BYTES, stream);
  if (e != hipSuccess) fprintf(stderr, "cooperative launch failed: %s (grid %d)\n", hipGetErrorString(e), grid_blocks);
}
```

```cpp
#include <hip/hip_runtime.h>
#include <hip/hip_cooperative_groups.h>
#include <cstdio>
namespace cg = cooperative_groups;

#define LAS __attribute__((address_space(3)))
typedef unsigned short bf16_t;
typedef short bf16x8 __attribute__((ext_vector_type(8)));
typedef float f32x4 __attribute__((ext_vector_type(4)));
typedef float f32x16 __attribute__((ext_vector_type(16)));
typedef unsigned u32x4 __attribute__((ext_vector_type(4)));
typedef unsigned u32x2 __attribute__((ext_vector_type(2)));
typedef float f32x2 __attribute__((ext_vector_type(2)));

constexpr int DM = 1024, NB = 4, SEQL = 4096, CTXL = 256, DEPTH = 4;
constexpr int MT = 17408, MLAT = 16384;
constexpr int PW = 2560, PWF = 2576, PWP = 2816;
constexpr float EPS = 1e-6f;
constexpr int NTHR = 512;
constexpr int LDS_BYTES = 143360;

__device__ __forceinline__ int ltid() { int t = threadIdx.x; asm volatile("" : "+v"(t)); return t; }
__device__ __forceinline__ float bf2f(bf16_t b) { return __uint_as_float(((unsigned)b) << 16); }
typedef __bf16 bf16x2_t __attribute__((ext_vector_type(2)));
__device__ __forceinline__ unsigned cvt_pk_bf16(float lo, float hi) { const f32x2 v = {lo, hi}; const bf16x2_t b = __builtin_convertvector(v, bf16x2_t); return __builtin_bit_cast(unsigned, b); }
__device__ __forceinline__ bf16_t f2bf(float f) { return (bf16_t)(cvt_pk_bf16(f, 0.f) & 0xffffu); }
__device__ __forceinline__ float wave_sum(float v) {
#pragma unroll
  for (int o = 32; o; o >>= 1) v += __shfl_xor(v, o);
  return v;
}
__device__ __forceinline__ float sigmoidf_(float x) { return 1.f / (1.f + __expf(-x)); }
__device__ __forceinline__ void lds_wait() { asm volatile("s_waitcnt lgkmcnt(0)" ::: "memory"); }

constexpr size_t al256(size_t x) { return (x + 255) & ~(size_t)255; }
constexpr size_t O_HSUM = 0;
constexpr size_t O_MOD = al256(O_HSUM + 4 * 2 * 2 * 256 * 4);
constexpr size_t O_ZEND = al256(O_MOD + 4 * 5 * 6144 * 4);
constexpr size_t O_S5AB = O_ZEND;
constexpr size_t O_BBT = al256(O_S5AB + 2 * 16 * 64 * 4 * 4);
constexpr size_t O_CMT = al256(O_BBT + 2 * 16 * 128 * 16 * 2);
constexpr size_t O_WQT = al256(O_CMT + 2 * 16 * 16 * 128 * 2);
constexpr size_t O_WKT = al256(O_WQT + 4 * 128 * 128 * 2);
constexpr size_t O_WGLUT = al256(O_WKT + 4 * 128 * 128 * 2);
constexpr size_t O_SC = al256(O_WGLUT + 256 * 256 * 2);
constexpr size_t O_HPART = al256(O_SC + 147456);
constexpr size_t SM_STRIDE = al256(O_HPART + (size_t)2 * 256 * 1024 * 4) - O_S5AB;
#define SM(l) ((size_t)(l) * SM_STRIDE)
constexpr size_t O_HFLAT = O_S5AB + 4 * SM_STRIDE;
constexpr size_t O_HFCTX = al256(O_HFLAT + (size_t)1024 * 4096 * 2);
constexpr size_t O_WINT = al256(O_HFCTX + (size_t)1024 * 256 * 2);
constexpr size_t O_WOUTT = al256(O_WINT + (size_t)PWP * 1024 * 2);
constexpr size_t O_W1T = al256(O_WOUTT + (size_t)1024 * 1024 * 2);
constexpr size_t O_W2T = al256(O_W1T + (size_t)4096 * 1024 * 2);
constexpr size_t O_CTX = al256(O_W2T + (size_t)4096 * 1024 * 2);
constexpr size_t O_ABUF = al256(O_CTX + (size_t)1024 * 1024 * 4);
constexpr size_t O_P = al256(O_ABUF + (size_t)MT * 1024 * 2);
constexpr size_t O_PG = al256(O_P + (size_t)MT * PW * 2);
constexpr size_t O_MIX = al256(O_PG + (size_t)MT * 16 * 4);
constexpr size_t O_HYT = O_MIX;
constexpr size_t O_YHYT = al256(O_HYT + (size_t)768 * MT * 2);
constexpr size_t O_Q = al256(O_YHYT + (size_t)256 * MT * 2);
constexpr size_t O_K = al256(O_Q + (size_t)MT * 512 * 2);
constexpr size_t O_XC = al256(O_K + (size_t)MT * 512 * 2);
constexpr size_t O_CST = al256(O_XC + (size_t)MT * 512 * 2);
constexpr size_t O_XEND = al256(O_CST + (size_t)544 * 129 * 128 * 4);
constexpr size_t S5ST_BYTES = (size_t)2 * 16 * 272 * 64 * 8;
constexpr size_t O_HIN = al256(O_XEND + S5ST_BYTES);
constexpr size_t O_YDIR = al256(O_HIN + S5ST_BYTES);
constexpr size_t O_HDIR = al256(O_YDIR + (size_t)2 * MT * 256 * 4);
constexpr size_t O_MIXEND = al256(O_HDIR + (size_t)2 * MT * 512 * 2);
constexpr size_t O_H1END = al256(O_MIX + (size_t)MT * 4096 * 2);
constexpr size_t WS_NEED = O_MIXEND > O_H1END ? O_MIXEND : O_H1END;

struct Params { const float* in[39]; float* out; unsigned char* ws; };
#define CPR const __attribute__((address_space(4))) Params&
namespace pg8 {
constexpr int BM = 256, BK = 64, HALF = 128, HTB = HALF * BK * 2, STAGE_BYTES = 8 * HTB, NXCD = 8, WGM = 8;
__host__ __device__ __forceinline__ int lds_byte(int r, int c) { const int st = (r >> 4) * 2 + (c >> 5), rr = r & 15, cc = c & 31, ob = rr * 64 + cc * 2; return st * 1024 + (ob ^ (((ob >> 9) & 1) << 5)); }
__host__ __device__ __forceinline__ void stage_rc(int b, int& R, int& C) { const int st = b / 1024, sb = b % 1024, swz = sb ^ (((sb >> 9) & 1) << 5); R = (st >> 1) * 16 + swz / 64; C = (st & 1) * 32 + (swz % 64) / 2; }
struct Unit { int pm, pn, kq; };
struct Gemm { const bf16_t* A; const bf16_t* Bt; int M, N, K, ld; };
struct StaticOrder {
    int nM, nN, nwg, G, c;
    __device__ void init(int M, int N, int G_, int c_) { nM = M / BM; nN = N / BM; nwg = nM * nN; G = G_; c = c_; }
    __device__ bool next(int i, Unit& u) const {
        const long L = (long)i * G + c; if (L >= nwg) return false;
        int wgid = (int)L; { const int q = nwg / NXCD, r = nwg % NXCD, xcd = wgid % NXCD, off = wgid / NXCD; wgid = (xcd < r ? xcd * (q + 1) : r * (q + 1) + (xcd - r) * q) + off; }
        const int nig = WGM * nN, gid = wgid / nig, fm = gid * WGM, gsz = (nM - fm) < WGM ? (nM - fm) : WGM;
        u.pm = fm + ((wgid % nig) % gsz); u.pn = (wgid % nig) / gsz; u.kq = 0; return true;
    }
};
struct CtxSplitOrder {
    int G, c;
    __device__ void init(int G_, int c_) { G = G_; c = c_; }
    __device__ bool next(int i, Unit& u) const { const int L = i * G + c; if (L >= 64) return false; u.kq = L & 3; u.pn = (L >> 2) & 3; u.pm = 64 + (L >> 4); return true; }
};
struct EpiF32 {
    float* C;
    __device__ __forceinline__ void operator()(const f32x4 (&acc)[2][2][4][2], const Unit& u, int wr, int wc, int fr, int fq) const {
        const int row0 = u.pm * BM + wr * 64 + fr, col0 = u.pn * BM + wc * 32 + 4 * fq;
#pragma unroll
        for (int ai = 0; ai < 2; ++ai)
#pragma unroll
            for (int m = 0; m < 4; ++m) { float* rowp = C + (size_t)(row0 + ai * HALF + m * 16) * 1024 + col0;
#pragma unroll
                for (int bj = 0; bj < 2; ++bj)
#pragma unroll
                    for (int n = 0; n < 2; ++n) *(f32x4*)(rowp + bj * HALF + n * 16) = acc[ai][bj][m][n]; }
    }
};
struct EpiF32Split {
    float* Y; float* Ypart;
    __device__ __forceinline__ void operator()(const f32x4 (&acc)[2][2][4][2], const Unit& u, int wr, int wc, int fr, int fq) const {
        const int row0 = u.pm * BM + wr * 64 + fr, col0 = u.pn * BM + wc * 32 + 4 * fq;
        float* C = u.kq == 0 ? Y : Ypart + (size_t)(u.kq - 1) * 1024 * 1024 - (size_t)MLAT * 1024;
#pragma unroll
        for (int ai = 0; ai < 2; ++ai)
#pragma unroll
            for (int m = 0; m < 4; ++m) { float* rowp = C + (size_t)(row0 + ai * HALF + m * 16) * 1024 + col0;
#pragma unroll
                for (int bj = 0; bj < 2; ++bj)
#pragma unroll
                    for (int n = 0; n < 2; ++n) *(f32x4*)(rowp + bj * HALF + n * 16) = acc[ai][bj][m][n]; }
    }
};
struct EpiP {
    bf16_t* P; float* pg;
    __device__ __forceinline__ void operator()(const f32x4 (&acc)[2][2][4][2], const Unit& u, int wr, int wc, int fr, int fq) const {
        const int row0 = u.pm * BM + wr * 64 + fr, col0 = u.pn * BM + wc * 32 + 4 * fq;
        if (u.pn < 10) {
#pragma unroll
            for (int ai = 0; ai < 2; ++ai)
#pragma unroll
                for (int m = 0; m < 4; ++m) { bf16_t* rowp = P + (size_t)(row0 + ai * HALF + m * 16) * PW + col0;
#pragma unroll
                    for (int bj = 0; bj < 2; ++bj)
#pragma unroll
                        for (int n = 0; n < 2; ++n) { const f32x4 v = acc[ai][bj][m][n]; u32x2 o; o.x = cvt_pk_bf16(v[0], v[1]); o.y = cvt_pk_bf16(v[2], v[3]); *(u32x2*)(rowp + bj * HALF + n * 16) = o; } }
        } else if (wc == 0) {
#pragma unroll
            for (int ai = 0; ai < 2; ++ai)
#pragma unroll
                for (int m = 0; m < 4; ++m) *(f32x4*)(pg + (size_t)(row0 + ai * HALF + m * 16) * 16 + 4 * fq) = acc[ai][0][m][0];
        }
    }
};
struct EpiRelu2 {
    bf16_t* O;
    __device__ __forceinline__ void operator()(const f32x4 (&acc)[2][2][4][2], const Unit& u, int wr, int wc, int fr, int fq) const {
        const int row0 = u.pm * BM + wr * 64 + fr, col0 = u.pn * BM + wc * 32 + 4 * fq;
#pragma unroll
        for (int ai = 0; ai < 2; ++ai)
#pragma unroll
            for (int m = 0; m < 4; ++m) { bf16_t* rowp = O + (size_t)(row0 + ai * HALF + m * 16) * 4096 + col0;
#pragma unroll
                for (int bj = 0; bj < 2; ++bj)
#pragma unroll
                    for (int n = 0; n < 2; ++n) { f32x4 v = acc[ai][bj][m][n];
#pragma unroll
                        for (int j = 0; j < 4; ++j) { const float t = fmaxf(v[j], 0.f); v[j] = t * t; }
                        u32x2 o; o.x = cvt_pk_bf16(v[0], v[1]); o.y = cvt_pk_bf16(v[2], v[3]); *(u32x2*)(rowp + bj * HALF + n * 16) = o; } }
    }
};

template <class Epi, class Sched>
__device__ __forceinline__ void gemm_phase(LAS unsigned char* lds, const Gemm g, const Sched& S, const Epi& E) {
    const int tid = ltid(), wid = __builtin_amdgcn_readfirstlane(tid >> 6), lane = tid & 63, wr = wid >> 2, wc = wid & 3, fr = lane & 15, fq = lane >> 4;
    const int K = g.K, nt = K / BK;
    unsigned voffA[2], voffB[2];
#pragma unroll
    for (int i = 0; i < 2; ++i) { int R, C; stage_rc(tid * 16 + i * 8192, R, C); voffA[i] = (unsigned)(R * g.ld + C) * 2u; voffB[i] = voffA[i]; }
    const size_t kstep = (size_t)(BK * 2);
    const size_t hstep = (size_t)HALF * g.ld * 2;
    const size_t qstep = (size_t)K * 2;
    const size_t tstep = 2 * hstep;
    const unsigned ldsw = (unsigned)wid * 1024u;
    const int aoff = lds_byte(wr * 64 + fr, fq * 8), boff = lds_byte(wc * 32 + fr, fq * 8);
#define PG8_SA(b, h) (((b) * 2 + (h)) * HTB)
#define PG8_SB(b, h) ((4 + (b) * 2 + (h)) * HTB)
#define PG8_STAGE(bufoff, gbase, voff) do { _Pragma("unroll") for (int _i = 0; _i < 2; ++_i) \
        __builtin_amdgcn_global_load_lds((const unsigned*)((const char*)(gbase) + (voff)[_i]), (LAS unsigned*)(lds + (bufoff) + ldsw + _i * 8192), 16, 0, 0); } while (0)
#define PG8_LDA(dst, b, h) do { _Pragma("unroll") for (int m = 0; m < 4; ++m) _Pragma("unroll") for (int k = 0; k < 2; ++k) dst[m][k] = *(const LAS bf16x8*)(lds + PG8_SA(b, h) + aoff + m * 2048 + k * 1024); } while (0)
#define PG8_LDB(dst, b, h) do { _Pragma("unroll") for (int n = 0; n < 2; ++n) _Pragma("unroll") for (int k = 0; k < 2; ++k) dst[n][k] = *(const LAS bf16x8*)(lds + PG8_SB(b, h) + boff + n * 2048 + k * 1024); } while (0)
#define PG8_MMA(ai, bj, At, Bt) do { __builtin_amdgcn_s_setprio(1); _Pragma("unroll") for (int m = 0; m < 4; ++m) _Pragma("unroll") for (int n = 0; n < 2; ++n) _Pragma("unroll") for (int k = 0; k < 2; ++k) \
        acc[ai][bj][m][n] = __builtin_amdgcn_mfma_f32_16x16x32_bf16(Bt[n][k], At[m][k], acc[ai][bj][m][n], 0, 0, 0); __builtin_amdgcn_s_setprio(0); } while (0)
#define PG8_WAIT_V(n) asm volatile("s_waitcnt vmcnt(" #n ")" ::: "memory")
#define PG8_WAIT_L(n) asm volatile("s_waitcnt lgkmcnt(" #n ")" ::: "memory")
#define PG8_BAR __builtin_amdgcn_s_barrier()
#define PG8_SCHED __builtin_amdgcn_sched_barrier(0)
    Unit cur, nxt; int ui = 0;
    if (!S.next(0, cur)) return;
    f32x4 acc[2][2][4][2];
#pragma unroll
    for (int a = 0; a < 2; ++a)
#pragma unroll
        for (int b = 0; b < 2; ++b)
#pragma unroll
            for (int m = 0; m < 4; ++m)
#pragma unroll
                for (int n = 0; n < 2; ++n) acc[a][b][m][n] = (f32x4){0.f, 0.f, 0.f, 0.f};
    bf16x8 At[4][2], B0[2][2], B1[2][2];
    const char* cA = (const char*)g.A + (size_t)cur.pm * tstep + (size_t)cur.kq * qstep; const char* cB = (const char*)g.Bt + (size_t)cur.pn * tstep + (size_t)cur.kq * qstep;
    PG8_STAGE(PG8_SB(0, 0), cB, voffB); PG8_STAGE(PG8_SA(0, 0), cA, voffA); PG8_STAGE(PG8_SB(0, 1), cB + hstep, voffB); PG8_STAGE(PG8_SA(0, 1), cA + hstep, voffA);
    if (wr == 1) PG8_BAR;
    PG8_WAIT_V(4); PG8_BAR;
    PG8_STAGE(PG8_SB(1, 0), cB + kstep, voffB); PG8_STAGE(PG8_SA(1, 0), cA + kstep, voffA); PG8_STAGE(PG8_SB(1, 1), cB + hstep + kstep, voffB);
    PG8_WAIT_V(6); PG8_BAR;
    for (;;) {
        const bool has_next = S.next(ui + 1, nxt);
        const char* nA = has_next ? (const char*)g.A + (size_t)nxt.pm * tstep + (size_t)nxt.kq * qstep : cA; const char* nB = has_next ? (const char*)g.Bt + (size_t)nxt.pn * tstep + (size_t)nxt.kq * qstep : cB;
        for (int t = 0; t < nt; t += 2) {
            const bool last = (t == nt - 2);
            const char* a1 = cA + (size_t)(t + 1) * kstep;
            const char* a2 = last ? nA : cA + (size_t)(t + 2) * kstep; const char* b2 = last ? nB : cB + (size_t)(t + 2) * kstep;
            const char* a3 = a2 + kstep; const char* b3 = b2 + kstep;
            PG8_LDB(B0, 0, 0); PG8_SCHED; PG8_LDA(At, 0, 0); PG8_STAGE(PG8_SA(1, 1), a1 + hstep, voffA);
            PG8_WAIT_L(8); PG8_BAR; PG8_WAIT_L(0); PG8_MMA(0, 0, At, B0); PG8_BAR; PG8_SCHED;
            PG8_LDB(B1, 0, 1); PG8_STAGE(PG8_SB(0, 0), b2, voffB);
            PG8_BAR; PG8_WAIT_L(0); PG8_MMA(0, 1, At, B1); PG8_BAR;
            PG8_LDA(At, 0, 1); PG8_STAGE(PG8_SA(0, 0), a2, voffA);
            PG8_BAR; PG8_WAIT_L(0); PG8_MMA(1, 0, At, B0); PG8_BAR; PG8_SCHED;
            PG8_STAGE(PG8_SB(0, 1), b2 + hstep, voffB);
            PG8_WAIT_V(6); PG8_BAR; PG8_MMA(1, 1, At, B1); PG8_BAR;
            PG8_LDB(B0, 1, 0); PG8_SCHED; PG8_LDA(At, 1, 0); PG8_STAGE(PG8_SA(0, 1), a2 + hstep, voffA);
            PG8_WAIT_L(8); PG8_BAR; PG8_WAIT_L(0); PG8_MMA(0, 0, At, B0); PG8_BAR; PG8_SCHED;
            PG8_LDB(B1, 1, 1); PG8_STAGE(PG8_SB(1, 0), b3, voffB);
            PG8_BAR; PG8_WAIT_L(0); PG8_MMA(0, 1, At, B1); PG8_BAR;
            PG8_LDA(At, 1, 1); PG8_STAGE(PG8_SA(1, 0), a3, voffA);
            PG8_BAR; PG8_WAIT_L(0); PG8_MMA(1, 0, At, B0); PG8_BAR; PG8_SCHED;
            PG8_STAGE(PG8_SB(1, 1), b3 + hstep, voffB);
            PG8_WAIT_V(6); PG8_BAR; PG8_MMA(1, 1, At, B1); PG8_BAR;
        }
        E(acc, cur, wr, wc, fr, fq);
        if (!has_next) break;
#pragma unroll
        for (int a = 0; a < 2; ++a)
#pragma unroll
            for (int b = 0; b < 2; ++b)
#pragma unroll
                for (int m = 0; m < 4; ++m)
#pragma unroll
                    for (int n = 0; n < 2; ++n) acc[a][b][m][n] = (f32x4){0.f, 0.f, 0.f, 0.f};
        cur = nxt; cA = nA; cB = nB; ++ui;
    }
    PG8_WAIT_V(0);
    if (wr == 0) PG8_BAR;
    PG8_BAR;
#undef PG8_SA
#undef PG8_SB
#undef PG8_STAGE
#undef PG8_LDA
#undef PG8_LDB
#undef PG8_MMA
#undef PG8_WAIT_V
#undef PG8_WAIT_L
#undef PG8_BAR
#undef PG8_SCHED
}
}
__device__ __forceinline__ int first_item(int off, int G) { int r = ((int)blockIdx.x - off) % G; if (r < 0) r += G; return r; }

__device__ __forceinline__ void phase_mod(CPR p, LAS unsigned char* lds) {
  LAS float* sc = (LAS float*)lds;
  LAS float* part = sc + 5 * 1024;
  const int tid = ltid(), wid = tid >> 6, lane = tid & 63;
  for (int i = tid; i < 5 * 1024; i += NTHR) {
    const int r = i >> 10, k = i & 1023;
    const float v = (r < 4) ? p.in[1][r * 1024 + k] : p.in[3][k];
    sc[i] = v / (1.f + __expf(-v));
  }
  __syncthreads();
  float* modt = (float*)(p.ws + O_MOD);
  for (int it = blockIdx.x; it < DEPTH * 96; it += gridDim.x) {
    const int l = it / 96, col = (it % 96) * 64 + lane;
    const float* w = p.in[4] + ((size_t)l * 1024 + wid * 128) * 6144 + col;
    float a0 = 0.f, a1 = 0.f, a2 = 0.f, a3 = 0.f, a4 = 0.f;
#pragma unroll 8
    for (int k = 0; k < 128; ++k) {
      const float wv = w[(size_t)k * 6144];
      const int kk = wid * 128 + k;
      a0 += sc[kk] * wv; a1 += sc[1024 + kk] * wv; a2 += sc[2048 + kk] * wv; a3 += sc[3072 + kk] * wv; a4 += sc[4096 + kk] * wv;
    }
    part[(wid * 5 + 0) * 64 + lane] = a0; part[(wid * 5 + 1) * 64 + lane] = a1; part[(wid * 5 + 2) * 64 + lane] = a2; part[(wid * 5 + 3) * 64 + lane] = a3; part[(wid * 5 + 4) * 64 + lane] = a4;
    __syncthreads();
    if (wid < 5) {
      float s = p.in[5][l * 6144 + col];
#pragma unroll
      for (int w8 = 0; w8 < 8; ++w8) s += part[(w8 * 5 + wid) * 64 + lane];
      modt[((size_t)l * 5 + wid) * 6144 + col] = s;
    }
    __syncthreads();
  }
}

__device__ __forceinline__ void conv_tile(LAS unsigned char* lds, const float* src, int ldsrc, int nvalid, bf16_t* dst, int K, int kt, int nt) {
  LAS float* T = (LAS float*)lds;
  __syncthreads();
  {
    const int j4 = (ltid() & 15) * 4, i0 = ltid() >> 4;
#pragma unroll
    for (int pss = 0; pss < 2; ++pss) {
      const int i = i0 + pss * 32;
      const int col = nt * 64 + j4;
      float4 v = make_float4(0.f, 0.f, 0.f, 0.f);
      if (col + 3 < nvalid) v = *(const float4*)(src + (size_t)(kt * 64 + i) * ldsrc + col);
      else { const float* s = src + (size_t)(kt * 64 + i) * ldsrc; if (col < nvalid) v.x = s[col]; if (col + 1 < nvalid) v.y = s[col + 1]; if (col + 2 < nvalid) v.z = s[col + 2]; }
      T[(j4 + 0) * 65 + i] = v.x; T[(j4 + 1) * 65 + i] = v.y; T[(j4 + 2) * 65 + i] = v.z; T[(j4 + 3) * 65 + i] = v.w;
    }
  }
  __syncthreads();
  {
    const int j = ltid() >> 3, i8 = (ltid() & 7) * 8;
    u32x4 o;
    o.x = cvt_pk_bf16(T[j * 65 + i8 + 0], T[j * 65 + i8 + 1]); o.y = cvt_pk_bf16(T[j * 65 + i8 + 2], T[j * 65 + i8 + 3]);
    o.z = cvt_pk_bf16(T[j * 65 + i8 + 4], T[j * 65 + i8 + 5]); o.w = cvt_pk_bf16(T[j * 65 + i8 + 6], T[j * 65 + i8 + 7]);
    *(u32x4*)(dst + (size_t)(nt * 64 + j) * K + kt * 64 + i8) = o;
  }
}

__device__ __forceinline__ void conv_tile4(LAS unsigned char* lds, const float* src, int ldsrc, int nvalid, bf16_t* dst, int K, int kt, int nt4) {
  LAS float* T = (LAS float*)lds;
  __syncthreads();
  {
    const int j4 = (ltid() & 15) * 4, i0 = ltid() >> 4;
    float4 v[4][2];
#pragma unroll
    for (int s4 = 0; s4 < 4; ++s4)
#pragma unroll
      for (int pss = 0; pss < 2; ++pss) {
        const int i = i0 + pss * 32; const int col = (nt4 * 4 + s4) * 64 + j4;
        v[s4][pss] = make_float4(0.f, 0.f, 0.f, 0.f);
        if (col + 3 < nvalid) v[s4][pss] = *(const float4*)(src + (size_t)(kt * 64 + i) * ldsrc + col);
      }
#pragma unroll
    for (int s4 = 0; s4 < 4; ++s4)
#pragma unroll
      for (int pss = 0; pss < 2; ++pss) {
        const int i = i0 + pss * 32; LAS float* Ts = T + s4 * 64 * 65;
        Ts[(j4 + 0) * 65 + i] = v[s4][pss].x; Ts[(j4 + 1) * 65 + i] = v[s4][pss].y; Ts[(j4 + 2) * 65 + i] = v[s4][pss].z; Ts[(j4 + 3) * 65 + i] = v[s4][pss].w;
      }
  }
  __syncthreads();
  {
    const int j = ltid() >> 3, i8 = (ltid() & 7) * 8;
#pragma unroll
    for (int s4 = 0; s4 < 4; ++s4) {
      LAS const float* Ts = T + s4 * 64 * 65 + j * 65 + i8;
      u32x4 o;
      o.x = cvt_pk_bf16(Ts[0], Ts[1]); o.y = cvt_pk_bf16(Ts[2], Ts[3]); o.z = cvt_pk_bf16(Ts[4], Ts[5]); o.w = cvt_pk_bf16(Ts[6], Ts[7]);
      *(u32x4*)(dst + (size_t)((nt4 * 4 + s4) * 64 + j) * K + kt * 64 + i8) = o;
    }
  }
}

constexpr int NCONV = 176 + 64 + 256 + 256 + 4 + 32;
__device__ __forceinline__ void conv_item(CPR p, LAS unsigned char* lds, int l, int it) {
  unsigned char* ws = p.ws;
  if (it < 176) { conv_tile4(lds, p.in[10] + (size_t)l * 1024 * PWF, PWF, PWF, (bf16_t*)(ws + O_WINT), 1024, it / 11, it % 11); return; }
  it -= 176;
  if (it < 64) { conv_tile4(lds, p.in[11] + (size_t)l * 1024 * 1024, 1024, 1024, (bf16_t*)(ws + O_WOUTT), 1024, it / 4, it % 4); return; }
  it -= 64;
  if (it < 256) { conv_tile4(lds, p.in[37] + (size_t)l * 1024 * 4096, 4096, 4096, (bf16_t*)(ws + O_W1T), 1024, it / 16, it % 16); return; }
  it -= 256;
  if (it < 256) { conv_tile4(lds, p.in[38] + (size_t)l * 4096 * 1024, 1024, 1024, (bf16_t*)(ws + O_W2T), 4096, it / 4, it % 4); return; }
  it -= 256;
  if (it < 4) { conv_tile4(lds, p.in[29] + (size_t)l * 256 * 256, 256, 256, (bf16_t*)(ws + O_WGLUT + SM(l)), 256, it, 0); return; }
  it -= 4;
  { const int which = it >> 4, h = (it >> 2) & 3, kt = (it >> 1) & 1, nt = it & 1;
    conv_tile(lds, p.in[which ? 33 : 32] + ((size_t)l * 4 + h) * 128 * 128, 128, 128, (bf16_t*)(ws + (which ? O_WKT : O_WQT) + SM(l)) + (size_t)h * 128 * 128, 128, kt, nt); }
}

__device__ __forceinline__ void hyfilt_item(CPR p, LAS unsigned char* lds, int l, int it) {
  const int which = it >= 256 ? 1 : 0; const int tt = which ? it - 256 : it; const int Ls = which ? CTXL : SEQL;
  LAS float* feat = (LAS float*)lds;
  LAS float* h1 = feat + 16 * 20;
  LAS float* h2 = h1 + 16 * 64;
  const int tid = ltid();
  __syncthreads();
  if (tid < 16 * 17) {
    const int i = tid / 17, e = tid % 17; const float t = (float)(tt * 16 + i) / (float)Ls;
    float v;
    if (e == 0) v = t; else if (e <= 8) v = cosf(6.283185307179586f * t * (float)e); else v = sinf(6.283185307179586f * t * (float)(e - 8));
    feat[i * 20 + e] = v;
  }
  __syncthreads();
  const float* w1 = p.in[13] + (size_t)l * 17 * 64; const float* b1 = p.in[14] + l * 64; const float* w2 = p.in[15] + (size_t)l * 64 * 64; const float* b2 = p.in[16] + l * 64;
  const float* w3 = p.in[17] + (size_t)l * 64 * 1024; const float* fr = p.in[18] + l * 64; const float* dec = p.in[19] + (size_t)l * 1024;
#pragma unroll 1
  for (int o = tid; o < 1024; o += NTHR) { const int i = o >> 6, f = o & 63; float a = b1[f];
#pragma unroll 1
    for (int e = 0; e < 17; ++e) a += feat[i * 20 + e] * w1[e * 64 + f];
    h1[o] = sinf(fr[f] * a); }
  __syncthreads();
#pragma unroll 1
  for (int o = tid; o < 1024; o += NTHR) { const int i = o >> 6, f = o & 63; float a = b2[f];
#pragma unroll 4
    for (int e = 0; e < 64; ++e) a += h1[i * 64 + e] * w2[e * 64 + f];
    h2[o] = sinf(fr[f] * a); }
  __syncthreads();
  float* hpart = (float*)(p.ws + O_HPART + SM(l)) + ((size_t)which * 256 + tt) * 1024;
  bf16_t* hout = (bf16_t*)(p.ws + (which ? O_HFCTX : O_HFLAT));
#pragma unroll 1
  for (int cc = 0; cc < 2; ++cc) {
    const int col = tid + cc * 512;
    float acc[16];
#pragma unroll
    for (int i = 0; i < 16; ++i) acc[i] = 0.f;
#pragma unroll 2
    for (int f = 0; f < 64; ++f) { const float w = w3[f * 1024 + col];
#pragma unroll
      for (int i = 0; i < 16; ++i) acc[i] += h2[i * 64 + f] * w; }
    const float dc = dec[col]; float ss = 0.f;
#pragma unroll
    for (int i = 0; i < 16; ++i) { const float t = (float)(tt * 16 + i) / (float)Ls; acc[i] *= expf(-t * dc); ss += acc[i] * acc[i]; }
    hpart[col] = ss;
    u32x4 o0, o1;
    o0.x = cvt_pk_bf16(acc[0], acc[1]); o0.y = cvt_pk_bf16(acc[2], acc[3]); o0.z = cvt_pk_bf16(acc[4], acc[5]); o0.w = cvt_pk_bf16(acc[6], acc[7]);
    o1.x = cvt_pk_bf16(acc[8], acc[9]); o1.y = cvt_pk_bf16(acc[10], acc[11]); o1.z = cvt_pk_bf16(acc[12], acc[13]); o1.w = cvt_pk_bf16(acc[14], acc[15]);
    bf16_t* d = hout + (size_t)col * Ls + tt * 16;
    *(u32x4*)d = o0; *(u32x4*)(d + 8) = o1;
  }
}

__device__ __forceinline__ void s5tab_item(CPR p, int l, int it) {
  const int idx = it * NTHR + ltid();
  const int n = idx & 63, dg = idx >> 6;
  const size_t base = (size_t)l * 2048 + idx;
  const float are = p.in[21][base], aim = p.in[22][base];
  const float dt = expf(p.in[23][l * 32 + dg]);
  const float zr = are * dt, zi = aim * dt;
  const float er = expf(zr), cs = cosf(zi), sn = sinf(zi);
  const float abr = er * cs, abi = er * sn;
  const float e64 = expf(64.f * zr), c64 = cosf(64.f * zi), s64 = sinf(64.f * zi);
  float* ab = (float*)(p.ws + O_S5AB + SM(l)) + (size_t)idx * 4;
  ab[0] = abr; ab[1] = abi; ab[2] = e64 * c64; ab[3] = e64 * s64;
  const float sh = sinf(0.5f * zi);
  const float mr = expm1f(zr) * cs - 2.f * sh * sh, mi = er * sn;
  const float den = 1.f / (are * are + aim * aim);
  const float cr = (mr * are + mi * aim) * den, ci = (mi * are - mr * aim) * den;
  bf16_t* bbt = (bf16_t*)(p.ws + O_BBT + SM(l)) + ((size_t)dg * 128 + 2 * n) * 16;
  const float* bre = p.in[24] + base * 16; const float* bim = p.in[25] + base * 16;
#pragma unroll
  for (int c = 0; c < 16; ++c) { const float br = bre[c], bi = bim[c]; bbt[c] = f2bf(cr * br - ci * bi); bbt[16 + c] = f2bf(cr * bi + ci * br); }
  bf16_t* cmt = (bf16_t*)(p.ws + O_CMT + SM(l)) + (size_t)dg * 16 * 128;
  const float* cre = p.in[26] + ((size_t)l * 32 + dg) * 1024; const float* cim = p.in[27] + ((size_t)l * 32 + dg) * 1024;
#pragma unroll
  for (int c = 0; c < 16; ++c) { cmt[c * 128 + 2 * n] = f2bf(cre[c * 64 + n]); cmt[c * 128 + 2 * n + 1] = f2bf(-cim[c * 64 + n]); }
}

struct RowCfg {
  const float* srcL; const float* srcC; float* dstL; float* dstC;
  const float* Y; const float* ypart; const float* gpost; const float* modA; int gate_off;
  const float* gpre; const float* modB; int sc_off, sh_off; bf16_t* abuf;
};
__device__ __forceinline__ void row_item(const RowCfg& c, int row) {
  const int lane = ltid() & 63;
  const bool isctx = row >= MLAT;
  const int mr = isctx ? 4 : (row >> 12);
  const float* src = isctx ? c.srcC + (size_t)(row - MLAT) * 1024 : c.srcL + (size_t)row * 1024;
  float* dst = isctx ? c.dstC + (size_t)(row - MLAT) * 1024 : c.dstL + (size_t)row * 1024;
  float4 x[4];
#pragma unroll
  for (int j = 0; j < 4; ++j) x[j] = *(const float4*)(src + j * 256 + lane * 4);
  if (c.Y) {
    float4 y[4]; float ss = 0.f;
#pragma unroll
    for (int j = 0; j < 4; ++j) { y[j] = *(const float4*)(c.Y + (size_t)row * 1024 + j * 256 + lane * 4);
      if (isctx && c.ypart) {
#pragma unroll
        for (int q = 0; q < 3; ++q) { const float4 t = *(const float4*)(c.ypart + ((size_t)q * 1024 + (row - MLAT)) * 1024 + j * 256 + lane * 4); y[j].x += t.x; y[j].y += t.y; y[j].z += t.z; y[j].w += t.w; }
      }
      ss += y[j].x * y[j].x + y[j].y * y[j].y + y[j].z * y[j].z + y[j].w * y[j].w; }
    ss = wave_sum(ss);
    const float r = rsqrtf(ss * (1.f / 1024.f) + EPS);
#pragma unroll
    for (int j = 0; j < 4; ++j) {
      const int col = j * 256 + lane * 4;
      const float4 gp = *(const float4*)(c.gpost + col); const float4 gt = *(const float4*)(c.modA + (size_t)mr * 6144 + c.gate_off + col);
      x[j].x += gt.x * (y[j].x * r * gp.x); x[j].y += gt.y * (y[j].y * r * gp.y); x[j].z += gt.z * (y[j].z * r * gp.z); x[j].w += gt.w * (y[j].w * r * gp.w);
    }
  }
  if (c.Y || dst != src) {
#pragma unroll
    for (int j = 0; j < 4; ++j) *(float4*)(dst + j * 256 + lane * 4) = x[j];
  }
  if (c.gpre) {
    float ss = 0.f;
#pragma unroll
    for (int j = 0; j < 4; ++j) ss += x[j].x * x[j].x + x[j].y * x[j].y + x[j].z * x[j].z + x[j].w * x[j].w;
    ss = wave_sum(ss);
    const float r = rsqrtf(ss * (1.f / 1024.f) + EPS);
#pragma unroll
    for (int j = 0; j < 4; ++j) {
      const int col = j * 256 + lane * 4;
      const float4 gp = *(const float4*)(c.gpre + col);
      const float4 s = *(const float4*)(c.modB + (size_t)mr * 6144 + c.sc_off + col); const float4 h = *(const float4*)(c.modB + (size_t)mr * 6144 + c.sh_off + col);
      u32x2 o;
      o.x = cvt_pk_bf16(x[j].x * r * gp.x * (1.f + s.x) + h.x, x[j].y * r * gp.y * (1.f + s.y) + h.y);
      o.y = cvt_pk_bf16(x[j].z * r * gp.z * (1.f + s.z) + h.z, x[j].w * r * gp.w * (1.f + s.w) + h.w);
      *(u32x2*)(c.abuf + (size_t)row * 1024 + col) = o;
    }
  }
}
__device__ __forceinline__ void row_block(const RowCfg& c, int W, bool hasctx) {
  const int lane = ltid() & 63; const int row0 = W * 8; const int mr = row0 >> 12;
  float4 A[4], Bm[4], H[4];
#pragma unroll
  for (int j = 0; j < 4; ++j) {
    const int col = j * 256 + lane * 4;
    A[j] = make_float4(0.f, 0.f, 0.f, 0.f); Bm[j] = A[j]; H[j] = A[j];
    if (c.Y) { const float4 gp = *(const float4*)(c.gpost + col); const float4 gt = *(const float4*)(c.modA + (size_t)mr * 6144 + c.gate_off + col);
      A[j] = make_float4(gp.x * gt.x, gp.y * gt.y, gp.z * gt.z, gp.w * gt.w); }
    if (c.gpre) { const float4 g = *(const float4*)(c.gpre + col); const float4 sv = *(const float4*)(c.modB + (size_t)mr * 6144 + c.sc_off + col);
      Bm[j] = make_float4(g.x * (1.f + sv.x), g.y * (1.f + sv.y), g.z * (1.f + sv.z), g.w * (1.f + sv.w)); H[j] = *(const float4*)(c.modB + (size_t)mr * 6144 + c.sh_off + col); }
  }
#pragma unroll 2
  for (int q = 0; q < 8; ++q) {
    const int row = row0 + q;
    const float* src = c.srcL + (size_t)row * 1024; float* dst = c.dstL + (size_t)row * 1024;
    float4 x[4];
#pragma unroll
    for (int j = 0; j < 4; ++j) x[j] = *(const float4*)(src + j * 256 + lane * 4);
    if (c.Y) {
      float4 y[4]; float ss = 0.f;
#pragma unroll
      for (int j = 0; j < 4; ++j) { y[j] = *(const float4*)(c.Y + (size_t)row * 1024 + j * 256 + lane * 4); ss += y[j].x * y[j].x + y[j].y * y[j].y + y[j].z * y[j].z + y[j].w * y[j].w; }
      ss = wave_sum(ss);
      const float r = rsqrtf(ss * (1.f / 1024.f) + EPS);
#pragma unroll
      for (int j = 0; j < 4; ++j) { x[j].x += A[j].x * (y[j].x * r); x[j].y += A[j].y * (y[j].y * r); x[j].z += A[j].z * (y[j].z * r); x[j].w += A[j].w * (y[j].w * r); }
    }
    if (c.Y || dst != src) {
#pragma unroll
      for (int j = 0; j < 4; ++j) *(float4*)(dst + j * 256 + lane * 4) = x[j];
    }
    if (c.gpre) {
      float ss = 0.f;
#pragma unroll
      for (int j = 0; j < 4; ++j) ss += x[j].x * x[j].x + x[j].y * x[j].y + x[j].z * x[j].z + x[j].w * x[j].w;
      ss = wave_sum(ss);
      const float r = rsqrtf(ss * (1.f / 1024.f) + EPS);
#pragma unroll
      for (int j = 0; j < 4; ++j) { u32x2 o;
        o.x = cvt_pk_bf16(x[j].x * r * Bm[j].x + H[j].x, x[j].y * r * Bm[j].y + H[j].y); o.y = cvt_pk_bf16(x[j].z * r * Bm[j].z + H[j].z, x[j].w * r * Bm[j].w + H[j].w);
        *(u32x2*)(c.abuf + (size_t)row * 1024 + j * 256 + lane * 4) = o; }
    }
  }
  if (hasctx && W < 1024) row_item(c, MLAT + W);
}

#define MFMA16(a, b, c) __builtin_amdgcn_mfma_f32_16x16x32_bf16(a, b, c, 0, 0, 0)
#define MFMA32(a, b, c) __builtin_amdgcn_mfma_f32_32x32x16_bf16(a, b, c, 0, 0, 0)

__device__ __forceinline__ void hyshort_item(CPR p, LAS unsigned char* lds, int l, int it) {
  const int ch = it / 3, cg4 = it % 3;
  const bf16_t* P = (const bf16_t*)(p.ws + O_P); bf16_t* hyT = (bf16_t*)(p.ws + O_HYT);
  LAS bf16_t* T = (LAS bf16_t*)lds;
  const int tid = ltid();
  const int tc = ch < 256 ? (ch & 63) : ((ch - 256) & 3); const int nch = ch < 256 ? 64 : 4;
  __syncthreads();
  {
    const int tau = tid >> 3, cb = (tid & 7) * 8; const int row = ch * 64 + tau;
    const bool hasm = !(tc == 0 && tau == 0), hasp = !(tc == nch - 1 && tau == 63);
    const bf16x8 zero = {0, 0, 0, 0, 0, 0, 0, 0};
    bf16x8 v0[4], vm[4], vp[4];
#pragma unroll
    for (int s4 = 0; s4 < 4; ++s4) { const int c0 = cg4 * 256 + s4 * 64 + cb;
      v0[s4] = *(const bf16x8*)(P + (size_t)row * PW + c0);
      vm[s4] = hasm ? *(const bf16x8*)(P + (size_t)(row - 1) * PW + c0) : zero;
      vp[s4] = hasp ? *(const bf16x8*)(P + (size_t)(row + 1) * PW + c0) : zero; }
#pragma unroll
    for (int s4 = 0; s4 < 4; ++s4) { const int c0 = cg4 * 256 + s4 * 64 + cb;
      const float* w = p.in[12] + (size_t)l * 3 * 768 + c0;
#pragma unroll
      for (int j = 0; j < 8; ++j) {
        const float o = w[j] * bf2f((bf16_t)vm[s4][j]) + w[768 + j] * bf2f((bf16_t)v0[s4][j]) + w[1536 + j] * bf2f((bf16_t)vp[s4][j]);
        T[(s4 * 64 + cb + j) * 72 + tau] = f2bf(o);
      } }
  }
  __syncthreads();
  {
    const int c = tid >> 3, t8 = (tid & 7) * 8;
#pragma unroll
    for (int s4 = 0; s4 < 4; ++s4) {
      const u32x4 v = *(const LAS u32x4*)(T + (s4 * 64 + c) * 72 + t8);
      *(u32x4*)(hyT + (size_t)(cg4 * 256 + s4 * 64 + c) * MT + ch * 64 + t8) = v; }
  }
}

__device__ __forceinline__ void mlqk_item(CPR p, LAS unsigned char* lds, int l, int it) {
  const int ch = it >> 2, h = it & 3;
  const bf16_t* P = (const bf16_t*)(p.ws + O_P);
  bf16_t* qb = (bf16_t*)(p.ws + O_Q); bf16_t* kb = (bf16_t*)(p.ws + O_K); bf16_t* xcb = (bf16_t*)(p.ws + O_XC);
  LAS bf16_t* XA = (LAS bf16_t*)lds;
  LAS bf16_t* WQ = XA + 64 * 136;
  LAS bf16_t* WK = WQ + 128 * 136;
  const int tid = ltid(), wid = tid >> 6, lane = tid & 63, cl = lane & 15, quad = lane >> 4;
  __syncthreads();
  {
    const bf16_t* wq = (const bf16_t*)(p.ws + O_WQT + SM(l)) + (size_t)h * 16384; const bf16_t* wk = (const bf16_t*)(p.ws + O_WKT + SM(l)) + (size_t)h * 16384;
    for (int i = tid; i < 2048; i += NTHR) { const int r = i >> 4, c8 = (i & 15) * 8;
      *(LAS u32x4*)(WQ + r * 136 + c8) = *(const u32x4*)(wq + r * 128 + c8); *(LAS u32x4*)(WK + r * 136 + c8) = *(const u32x4*)(wk + r * 128 + c8); }
  }
  {
    const int tau = tid >> 3, cb = (tid & 7) * 16; const int cch = h * 128 + cb;
    const bool lat = ch < 256;
    const int seqbase = lat ? (ch >> 6) * 4096 : MLAT + ((ch - 256) >> 2) * 256;
    const int tloc = lat ? (ch & 63) * 64 + tau : ((ch - 256) & 3) * 64 + tau;
    const float* cw = p.in[31] + (size_t)l * 9 * 512 + cch;
    float acc[16];
#pragma unroll
    for (int j = 0; j < 16; ++j) acc[j] = 0.f;
#pragma unroll
    for (int di = 0; di < 3; ++di) {
      if (!lat && di != 1) continue;
#pragma unroll
      for (int dj = 0; dj < 3; ++dj) {
        bool ok; int ts;
        if (lat) { const int r = (tloc >> 6) + di - 1, cc = (tloc & 63) + dj - 1; ok = (r >= 0 && r < 64 && cc >= 0 && cc < 64); ts = r * 64 + cc; }
        else { ts = tloc + dj - 1; ok = (ts >= 0 && ts < 256); }
        if (ok) {
          const bf16_t* src = P + (size_t)(seqbase + ts) * PW + 1024 + cch;
          const bf16x8 v0 = *(const bf16x8*)src, v1 = *(const bf16x8*)(src + 8);
          const float* w = cw + (di * 3 + dj) * 512;
#pragma unroll
          for (int j = 0; j < 8; ++j) { acc[j] += w[j] * bf2f((bf16_t)v0[j]); acc[8 + j] += w[8 + j] * bf2f((bf16_t)v1[j]); }
        }
      }
    }
#pragma unroll
    for (int j = 0; j < 16; ++j) acc[j] = acc[j] / (1.f + __expf(-acc[j]));
    u32x4 o0, o1;
    o0.x = cvt_pk_bf16(acc[0], acc[1]); o0.y = cvt_pk_bf16(acc[2], acc[3]); o0.z = cvt_pk_bf16(acc[4], acc[5]); o0.w = cvt_pk_bf16(acc[6], acc[7]);
    o1.x = cvt_pk_bf16(acc[8], acc[9]); o1.y = cvt_pk_bf16(acc[10], acc[11]); o1.z = cvt_pk_bf16(acc[12], acc[13]); o1.w = cvt_pk_bf16(acc[14], acc[15]);
    *(LAS u32x4*)(XA + tau * 136 + cb) = o0; *(LAS u32x4*)(XA + tau * 136 + cb + 8) = o1;
    bf16_t* xo = xcb + (size_t)(ch * 64 + tau) * 512 + cch;
    *(u32x4*)xo = o0; *(u32x4*)(xo + 8) = o1;
  }
  __syncthreads();
#pragma unroll 1
  for (int ti = 0; ti < 8; ++ti) {
    const int t = wid * 8 + ti; const int mat = t >> 5, rt = (t >> 3) & 3, ct = t & 7;
    LAS const bf16_t* W = mat ? WK : WQ;
    f32x4 acc = {0.f, 0.f, 0.f, 0.f};
#pragma unroll
    for (int ks = 0; ks < 4; ++ks) {
      const bf16x8 a = *(LAS const bf16x8*)(XA + (rt * 16 + cl) * 136 + ks * 32 + quad * 8);
      const bf16x8 b = *(LAS const bf16x8*)(W + (ct * 16 + cl) * 136 + ks * 32 + quad * 8);
      acc = MFMA16(a, b, acc);
    }
    bf16_t* o = (mat ? kb : qb) + (size_t)(ch * 64 + rt * 16 + quad * 4) * 512 + h * 128 + ct * 16 + cl;
    const float sc = mat ? 0.08838834764831845f : 1.f;
#pragma unroll
    for (int i = 0; i < 4; ++i) o[(size_t)i * 512] = f2bf(acc[i] * sc);
  }
}

template <bool OUT>
__device__ __forceinline__ void s5_chunk(CPR p, LAS unsigned char* Lw, int wi, int l, bool first) {
  const int lane = ltid() & 63, cl = lane & 15, quad = lane >> 4;
  const int dg = wi / 272, ch = wi % 272; const int dir = dg >> 4, g = dg & 15;
  const bf16_t* P = (const bf16_t*)(p.ws + O_P);
  LAS float* BUs = (LAS float*)Lw;
  LAS bf16_t* Xs = (LAS bf16_t*)(Lw + 16 * 132 * 4);
  const bf16x8 zero = {0, 0, 0, 0, 0, 0, 0, 0};
  bf16x8 bb[8];
  const bf16_t* bbt = (const bf16_t*)(p.ws + O_BBT + SM(l)) + (size_t)dg * 128 * 16;
#pragma unroll
  for (int j = 0; j < 8; ++j) bb[j] = quad < 2 ? *(const bf16x8*)(bbt + (16 * j + cl) * 16 + 8 * quad) : zero;
  bf16x8 cf[4];
  if (OUT) { const bf16_t* cmt = (const bf16_t*)(p.ws + O_CMT + SM(l)) + (size_t)dg * 16 * 128;
#pragma unroll
    for (int kk = 0; kk < 4; ++kk) cf[kk] = *(const bf16x8*)(cmt + cl * 128 + 32 * kk + 8 * quad); }
  const float* ab = (const float*)(p.ws + O_S5AB + SM(l)) + ((size_t)dg * 64 + lane) * 4;
  const float ar = ab[0], ai = ab[1];
  float xr = 0.f, xi = 0.f;
  const size_t sidx = ((size_t)dg * 272 + ch) * 64 + lane;
  if (OUT && !first) { const float2 h0 = ((const float2*)(p.ws + O_HIN))[sidx]; xr = h0.x; xi = h0.y; }
  float* Yd = (float*)(p.ws + O_YDIR) + (size_t)dg * MT * 16;
#pragma unroll 1
  for (int sb = 0; sb < 4; ++sb) {
    const int pos = 16 * sb + cl; const int tok = dir ? 63 - pos : pos;
    const bf16x8 a = quad < 2 ? *(const bf16x8*)(P + (size_t)(ch * 64 + tok) * PW + 768 + g * 16 + 8 * quad) : zero;
#pragma unroll
    for (int j = 0; j < 8; ++j) {
      f32x4 acc = {0.f, 0.f, 0.f, 0.f};
      acc = MFMA16(a, bb[j], acc);
#pragma unroll
      for (int i = 0; i < 4; ++i) BUs[(quad * 4 + i) * 132 + 16 * j + cl] = acc[i];
    }
    lds_wait();
#pragma unroll
    for (int t = 0; t < 16; ++t) {
      const f32x2 bu = *(LAS const f32x2*)(BUs + t * 132 + 2 * lane);
      float nr = ar * xr - ai * xi + bu.x, ni = ar * xi + ai * xr + bu.y;
      asm volatile("" : "+v"(nr), "+v"(ni));
      xr = nr; xi = ni;
      if (OUT && !first) *(LAS unsigned*)(Xs + t * 136 + 2 * lane) = cvt_pk_bf16(xr, xi);
    }
    if (OUT && !first) {
      lds_wait();
      f32x4 acc = {0.f, 0.f, 0.f, 0.f};
#pragma unroll
      for (int kk = 0; kk < 4; ++kk) { const bf16x8 af = *(LAS const bf16x8*)(Xs + cl * 136 + 32 * kk + 8 * quad); acc = MFMA16(af, cf[kk], acc); }
#pragma unroll
      for (int i = 0; i < 4; ++i) { const int ps = 16 * sb + quad * 4 + i; const int tk = dir ? 63 - ps : ps; Yd[(size_t)(ch * 64 + tk) * 16 + cl] = acc[i]; }
    }
    lds_wait();
  }
  if (!OUT || first) ((float2*)(p.ws + O_XEND))[sidx] = make_float2(xr, xi);
}

__device__ __forceinline__ void s5_carry_item(CPR p, int it, int l) {
  const int idx = it * NTHR + ltid();
  const int n = idx & 63, g = (idx >> 6) & 15, b = (idx >> 10) & 3, dir = idx >> 12;
  const int dg = dir * 16 + g;
  const float* ab = (const float*)(p.ws + O_S5AB + SM(l)) + ((size_t)dg * 64 + n) * 4;
  const float ar = ab[2], ai = ab[3];
  const float2* xe = (const float2*)(p.ws + O_XEND) + (size_t)dg * 272 * 64 + n; float2* hin = (float2*)(p.ws + O_HIN) + (size_t)dg * 272 * 64 + n;
  float hr = 0.f, hi = 0.f;
#pragma unroll 1
  for (int base = 0; base < 68; base += 17) {
    float2 e[17];
#pragma unroll
    for (int j = 0; j < 17; ++j) { const int sp = base + j; const int ch = sp < 4 ? 256 + b * 4 + (dir ? 3 - sp : sp) : b * 64 + (dir ? 63 - (sp - 4) : sp - 4); e[j] = xe[(size_t)ch * 64]; }
#pragma unroll
    for (int j = 0; j < 17; ++j) { const int sp = base + j; const int ch = sp < 4 ? 256 + b * 4 + (dir ? 3 - sp : sp) : b * 64 + (dir ? 63 - (sp - 4) : sp - 4);
      hin[(size_t)ch * 64] = make_float2(hr, hi);
      const float nr = ar * hr - ai * hi + e[j].x, ni = ar * hi + ai * hr + e[j].y; hr = nr; hi = ni; }
  }
}

constexpr int UST = 4616;
constexpr int RST = 8200;
__device__ __forceinline__ void hyena_seq(CPR p, LAS unsigned char* lds, int l, int c, int which) {
  const int Ls = which ? CTXL : SEQL; const int rowbase = which ? MLAT : 0; const int ncg = Ls / 256;
  const bf16_t* hflt = (const bf16_t*)(p.ws + (which ? O_HFCTX : O_HFLAT));
  const float* hpart = (const float*)(p.ws + O_HPART + SM(l)) + (size_t)which * 256 * 1024;
  LAS float* red = (LAS float*)(lds + 4 * RST * 2 + 4 * UST * 2);
  const bf16_t* hyT = (const bf16_t*)(p.ws + O_HYT); bf16_t* yhyT = (bf16_t*)(p.ws + O_YHYT);
  LAS bf16_t* R0 = (LAS bf16_t*)lds; LAS bf16_t* U = R0 + 4 * RST;
  const int tid = ltid(), wid = tid >> 6, lane = tid & 63, n = lane & 31, hh = lane >> 5, q = n >> 2, b = n & 3;
  const int cg0 = 2 * wid; const bool act = cg0 < ncg; const bool has2 = (cg0 + 1) < ncg; const int T0 = cg0 * 256;
  float z1[2][16];
#pragma unroll
  for (int g2 = 0; g2 < 2; ++g2)
#pragma unroll
    for (int i = 0; i < 16; ++i) z1[g2][i] = 0.f;
  __syncthreads();
  {
    const int ntt = Ls / 16;
#pragma unroll
    for (int od = 0; od < 2; ++od) {
      float v = 0.f;
      if (tid < 2 * ntt) v = hpart[(size_t)(tid >> 1) * 1024 + od * 512 + (tid & 1) * 256 + c];
      v = wave_sum(v);
      if (lane == 0) red[od * 8 + wid] = v;
    }
    __syncthreads();
    if (tid < 2) { float s = 0.f; for (int w = 0; w < 8; ++w) s += red[tid * 8 + w]; red[16 + tid] = s; }
  }
#pragma unroll 1
  for (int order = 0; order < 2; ++order) {
    __syncthreads();
    const bf16_t* hf = hflt + ((size_t)(order * 2 + 0) * 256 + c) * Ls; const bf16_t* hb = hflt + ((size_t)(order * 2 + 1) * 256 + c) * Ls;
    for (int ci = tid; ci < Ls / 4; ci += NTHR) {
      const bool bw = ci >= Ls / 8; const int x0 = (bw ? ci - Ls / 8 : ci) * 8;
      const bf16x8 v = *(const bf16x8*)((bw ? hb : hf) + x0);
#pragma unroll
      for (int j = 0; j < 8; ++j) {
        const int x = x0 + j; const int i = bw ? Ls - 1 + x : Ls - 1 - x;
        if (!(bw && x == 0)) {
#pragma unroll
          for (int k = 0; k < 4; ++k) if (i - k >= 0) R0[k * RST + i - k] = (bf16_t)v[j];
        }
      }
    }
    if (order == 0) {
      const int nch = Ls / 8, npad = UST - Ls;
      for (int idx = tid; idx < 4 * nch; idx += NTHR) { const int bb = idx / nch, t8 = (idx % nch) * 8;
        *(LAS u32x4*)(U + bb * UST + 224 + t8) = *(const u32x4*)(hyT + (size_t)c * MT + rowbase + bb * Ls + t8); }
      for (int idx = tid; idx < 4 * npad; idx += NTHR) { const int bb = idx / npad, pp = idx % npad; U[bb * UST + (pp < 224 ? pp : pp + Ls)] = 0; }
    } else if (act) {
#pragma unroll
      for (int g2 = 0; g2 < 2; ++g2) if (g2 == 0 || has2)
#pragma unroll
        for (int i4 = 0; i4 < 4; ++i4) { const int t = T0 + g2 * 256 + 32 * q + 8 * i4 + 4 * hh;
          u32x2 o; o.x = cvt_pk_bf16(z1[g2][4 * i4], z1[g2][4 * i4 + 1]); o.y = cvt_pk_bf16(z1[g2][4 * i4 + 2], z1[g2][4 * i4 + 3]);
          *(LAS u32x2*)(U + b * UST + 224 + t) = o; }
    }
    __syncthreads();
    f32x16 acc0, acc1;
#pragma unroll
    for (int i = 0; i < 16; ++i) { acc0[i] = 0.f; acc1[i] = 0.f; }
    if (act) {
      const int e_lo = T0 - (Ls - 16), e_hi = (has2 ? T0 + 256 : T0) + 224;
      if (has2) {
        const bf16x8 z8 = {0, 0, 0, 0, 0, 0, 0, 0};
        bf16x8 r0 = z8, r1 = z8, r2 = z8, r3 = z8, r4 = z8, r5 = z8, r6 = z8, r7 = z8, r8 = z8, r9 = z8, r10 = z8, r11 = z8, r12 = z8, r13 = z8, r14 = z8, r15 = z8;
        const int o_lo = (Ls - 1) - e_lo - n + 8 * hh; const int kk = o_lo & 3;
        LAS const bf16_t* Rp = R0 + kk * RST + (o_lo - kk);
        LAS const bf16_t* Up = U + b * UST + 224 + (T0 + 32 * q - e_lo + 8 * hh);
#define HY_AF(j) const u32x2 a0 = *(LAS const u32x2*)(pa + 16 * (15 - (j))), a1 = *(LAS const u32x2*)(pa + 16 * (15 - (j)) + 4); u32x4 av; av.x = a0.x; av.y = a0.y; av.z = a1.x; av.w = a1.y; const bf16x8 af = __builtin_bit_cast(bf16x8, av);
#define HY_G0(j)   { HY_AF(j) const bf16x8 bf = *(LAS const bf16x8*)(pb + 16 * (15 - (j))); acc0 = MFMA32(af, bf, acc0); r##j = bf; }
#define HY_BOTH(j) { HY_AF(j) acc1 = MFMA32(af, r##j, acc1); const bf16x8 bf = *(LAS const bf16x8*)(pb + 16 * (15 - (j))); acc0 = MFMA32(af, bf, acc0); r##j = bf; }
#define HY_G1(j)   { HY_AF(j) acc1 = MFMA32(af, r##j, acc1); }
#define HY_SB __builtin_amdgcn_sched_barrier(0);
        { LAS const bf16_t* pa = Rp - 16 * 15; LAS const bf16_t* pb = Up - 16 * 15;
          HY_G0(0) HY_G0(1) HY_G0(2) HY_G0(3) HY_SB HY_G0(4) HY_G0(5) HY_G0(6) HY_G0(7) HY_SB HY_G0(8) HY_G0(9) HY_G0(10) HY_G0(11) HY_SB HY_G0(12) HY_G0(13) HY_G0(14) HY_G0(15) HY_SB }
        const int nb = Ls / 256 - 1;
#pragma unroll 1
        for (int blk = 1; blk <= nb; ++blk) {
          LAS const bf16_t* pa = Rp - 16 * (16 * blk + 15); LAS const bf16_t* pb = Up - 16 * (16 * blk + 15);
          HY_BOTH(0) HY_BOTH(1) HY_BOTH(2) HY_BOTH(3) HY_SB HY_BOTH(4) HY_BOTH(5) HY_BOTH(6) HY_BOTH(7) HY_SB HY_BOTH(8) HY_BOTH(9) HY_BOTH(10) HY_BOTH(11) HY_SB HY_BOTH(12) HY_BOTH(13) HY_BOTH(14) HY_BOTH(15) HY_SB
        }
        { LAS const bf16_t* pa = Rp - 16 * (16 * (nb + 1) + 15); LAS const bf16_t* pb = Up - 16 * (16 * (nb + 1) + 15);
          HY_BOTH(0) HY_BOTH(1) HY_BOTH(2) HY_BOTH(3) HY_SB HY_BOTH(4) HY_BOTH(5) HY_BOTH(6) HY_BOTH(7) HY_SB HY_BOTH(8) HY_BOTH(9) HY_BOTH(10) HY_BOTH(11) HY_SB HY_BOTH(12) HY_BOTH(13) HY_G1(14) HY_G1(15) HY_SB }
        { LAS const bf16_t* pa = Rp - 16 * (16 * (nb + 2) + 15);
          HY_G1(0) HY_G1(1) HY_G1(2) HY_G1(3) HY_SB HY_G1(4) HY_G1(5) HY_G1(6) HY_G1(7) HY_SB HY_G1(8) HY_G1(9) HY_G1(10) HY_G1(11) HY_SB HY_G1(12) HY_G1(13) HY_SB }
#undef HY_AF
#undef HY_G0
#undef HY_BOTH
#undef HY_G1
#undef HY_SB
      } else {
#pragma unroll 2
        for (int e = e_lo; e <= e_hi; e += 16) {
          const int o = (Ls - 1) - e - n + 8 * hh;
          const int kk = o & 3;
          LAS const u32x2* Rw = (LAS const u32x2*)(R0 + kk * RST + (o - kk));
          const u32x2 a0 = Rw[0], a1 = Rw[1];
          u32x4 av; av.x = a0.x; av.y = a0.y; av.z = a1.x; av.w = a1.y;
          const bf16x8 af = __builtin_bit_cast(bf16x8, av);
          const int s = T0 + 32 * q - e + 8 * hh; const bf16x8 bf = *(LAS const bf16x8*)(U + b * UST + 224 + s); acc0 = MFMA32(af, bf, acc0);
        }
      }
      const float scale = rsqrtf(red[16 + order] + EPS); const float bias = p.in[20][(size_t)l * 512 + order * 256 + c];
#pragma unroll
      for (int g2 = 0; g2 < 2; ++g2) if (g2 == 0 || has2) {
#pragma unroll
        for (int i4 = 0; i4 < 4; ++i4) {
          const int t = T0 + g2 * 256 + 32 * q + 8 * i4 + 4 * hh; const size_t row = (size_t)rowbase + b * Ls + t;
          const u32x2 gv = *(const u32x2*)(hyT + (size_t)((order + 1) * 256 + c) * MT + row);
          float gt[4] = {__uint_as_float(gv.x << 16), __uint_as_float(gv.x & 0xffff0000u), __uint_as_float(gv.y << 16), __uint_as_float(gv.y & 0xffff0000u)};
          float r[4];
          if (order == 0) {
            const u32x2 zv = *(LAS const u32x2*)(U + b * UST + 224 + t);
            float z0[4] = {__uint_as_float(zv.x << 16), __uint_as_float(zv.x & 0xffff0000u), __uint_as_float(zv.y << 16), __uint_as_float(zv.y & 0xffff0000u)};
#pragma unroll
            for (int j = 0; j < 4; ++j) { const float cv = (g2 ? acc1[4 * i4 + j] : acc0[4 * i4 + j]) * scale; r[j] = gt[j] * (cv + bias * z0[j]); z1[g2][4 * i4 + j] = r[j]; }
          } else {
#pragma unroll
            for (int j = 0; j < 4; ++j) { const float cv = (g2 ? acc1[4 * i4 + j] : acc0[4 * i4 + j]) * scale; r[j] = gt[j] * (cv + bias * z1[g2][4 * i4 + j]); }
            u32x2 o; o.x = cvt_pk_bf16(r[0], r[1]); o.y = cvt_pk_bf16(r[2], r[3]);
            *(u32x2*)(yhyT + (size_t)c * MT + row) = o;
          }
        }
      }
    }
  }
}

__device__ __forceinline__ void hytrans_item(CPR p, LAS unsigned char* lds, int it) {
  const int ch = it;
  const bf16_t* yhyT = (const bf16_t*)(p.ws + O_YHYT); bf16_t* ymix = (bf16_t*)(p.ws + O_ABUF);
  LAS bf16_t* T = (LAS bf16_t*)lds;
  const int tid = ltid();
  __syncthreads();
  { const int c = tid >> 3, t8 = (tid & 7) * 8;
    bf16x8 v[4];
#pragma unroll
    for (int s4 = 0; s4 < 4; ++s4) v[s4] = *(const bf16x8*)(yhyT + (size_t)(s4 * 64 + c) * MT + ch * 64 + t8);
#pragma unroll
    for (int s4 = 0; s4 < 4; ++s4)
#pragma unroll
      for (int j = 0; j < 8; ++j) T[(t8 + j) * 264 + s4 * 64 + c] = (bf16_t)v[s4][j]; }
  __syncthreads();
  { const int t = tid >> 3, c8 = (tid & 7) * 8;
#pragma unroll
    for (int s4 = 0; s4 < 4; ++s4) *(u32x4*)(ymix + (size_t)(ch * 64 + t) * 1024 + s4 * 64 + c8) = *(LAS const u32x4*)(T + t * 264 + s4 * 64 + c8); }
}

struct MlItem { int dir, b, h, sp, rb; };
__device__ __forceinline__ MlItem ml_decode(int it) {
  MlItem m; m.sp = it % 17; const int c = it / 17; m.h = c & 3; m.b = (c >> 2) & 3; m.dir = c >> 4;
  if (m.sp == 0) m.rb = MLAT + m.b * 256; else { const int bc = m.dir ? 16 - m.sp : m.sp - 1; m.rb = m.b * 4096 + bc * 256; }
  return m;
}
__device__ __forceinline__ void ml_gate_scan(CPR p, int l, const MlItem& m, LAS float* bcsA, LAS float* colvA, LAS float* pmaxA, LAS float* tmp) {
  const int tid = ltid(), wid = tid >> 6, lane = tid & 63;
  float v = 0.f, ir = 0.f;
  if (tid < 256) {
    const int row = m.rb + (m.dir ? 255 - tid : tid);
    const float* pg = (const float*)(p.ws + O_PG) + (size_t)row * 16;
    const float* gb = p.in[34] + (size_t)l * 16;
    ir = pg[m.dir * 8 + m.h] + gb[(m.dir * 2) * 4 + m.h];
    const float fr = pg[m.dir * 8 + 4 + m.h] + gb[(m.dir * 2 + 1) * 4 + m.h];
    v = fminf(fr, 0.f) - log1pf(expf(-fabsf(fr)));
#pragma unroll
    for (int o = 1; o < 64; o <<= 1) { const float t = __shfl_up(v, o); if (lane >= o) v += t; }
    if (lane == 63) tmp[wid] = v;
  }
  __syncthreads();
  float cv = 0.f;
  if (tid < 256) {
    float pre = 0.f; for (int w = 0; w < wid; ++w) pre += tmp[w];
    v += pre; cv = ir - v;
    float pm = cv;
#pragma unroll
    for (int o = 1; o < 64; o <<= 1) { const float t = __shfl_up(pm, o); if (lane >= o) pm = fmaxf(pm, t); }
    if (lane == 63) tmp[8 + wid] = pm;
    bcsA[tid] = v; colvA[tid] = cv; pmaxA[tid] = pm;
  }
  __syncthreads();
  if (tid < 256) { float pm = pmaxA[tid]; for (int w = 0; w < wid; ++w) pm = fmaxf(pm, tmp[8 + w]); pmaxA[tid] = pm; }
  __syncthreads();
}

__device__ __forceinline__ void ml_cloc_item(CPR p, LAS unsigned char* lds, int l, int it) {
  const MlItem m = ml_decode(it);
  const bf16_t* P = (const bf16_t*)(p.ws + O_P); const bf16_t* kb = (const bf16_t*)(p.ws + O_K);
  LAS bf16_t* VW = (LAS bf16_t*)lds;
  LAS bf16_t* KT = VW + 144 * 136;
  LAS float* bcsA = (LAS float*)(KT + 128 * 136); LAS float* colvA = bcsA + 256; LAS float* pmaxA = colvA + 256; LAS float* wA = pmaxA + 256; LAS float* tmp = wA + 256;
  const int tid = ltid(), wid = tid >> 6, lane = tid & 63, cl = lane & 15, quad = lane >> 4;
  __syncthreads();
  ml_gate_scan(p, l, m, bcsA, colvA, pmaxA, tmp);
  const float maxcv = pmaxA[255], gtot = bcsA[255];
  if (tid < 256) wA[tid] = __expf(colvA[tid] - maxcv);
  for (int i = tid; i < 15 * 136; i += NTHR) VW[129 * 136 + i] = 0;
  f32x4 acc[9];
#pragma unroll
  for (int r = 0; r < 9; ++r) acc[r] = (f32x4){0.f, 0.f, 0.f, 0.f};
#pragma unroll 1
  for (int half = 0; half < 2; ++half) {
    __syncthreads();
    {
      const int tl = tid & 127, db = (tid >> 7) * 32; const int tau = half * 128 + tl;   const int row = m.rb + (m.dir ? 255 - tau : tau);
      const float w = wA[tau];
      const bf16_t* vs = P + (size_t)row * PW + 1536 + m.h * 128 + db; const bf16_t* ks = kb + (size_t)row * 512 + m.h * 128 + db;
#pragma unroll
      for (int g4 = 0; g4 < 4; ++g4) {
        const bf16x8 vv = *(const bf16x8*)(vs + g4 * 8), kv = *(const bf16x8*)(ks + g4 * 8);
#pragma unroll
        for (int j = 0; j < 8; ++j) { VW[(db + g4 * 8 + j) * 136 + tl] = f2bf(bf2f((bf16_t)vv[j]) * w); KT[(db + g4 * 8 + j) * 136 + tl] = (bf16_t)kv[j]; }
      }
      if (tid < 128) VW[128 * 136 + tl] = f2bf(w);
    }
    __syncthreads();
#pragma unroll
    for (int ks = 0; ks < 4; ++ks) {
      const bf16x8 bf = *(LAS const bf16x8*)(KT + (16 * wid + cl) * 136 + 32 * ks + 8 * quad);
#pragma unroll
      for (int r = 0; r < 9; ++r) { const bf16x8 af = *(LAS const bf16x8*)(VW + (16 * r + cl) * 136 + 32 * ks + 8 * quad); acc[r] = MFMA16(af, bf, acc[r]); }
    }
  }
  float* cst = (float*)(p.ws + O_CST) + (size_t)it * 129 * 128;
#pragma unroll
  for (int r = 0; r < 9; ++r)
#pragma unroll
    for (int i = 0; i < 4; ++i) { const int d = 16 * r + quad * 4 + i; if (d < 129) cst[(size_t)d * 128 + 16 * wid + cl] = acc[r][i]; }
  if (tid == 0) { float* sc = (float*)(p.ws + O_SC + SM(l)); sc[it * 32] = gtot + maxcv; sc[it * 32 + 1] = gtot; }
}

__device__ __forceinline__ void ml_carry(CPR p, int l) {
  float* cst = (float*)(p.ws + O_CST); const float* sc = (const float*)(p.ws + O_SC + SM(l)); float* mprev = (float*)(p.ws + O_SC + SM(l)) + 544 * 32;
  const int total = 32 * 129 * 128;
  for (int idx = blockIdx.x * NTHR + ltid(); idx < total; idx += gridDim.x * NTHR) {
    const int chain = idx / (129 * 128), el = idx % (129 * 128);
    float cj[17], mj[17], gj[17];
#pragma unroll
    for (int sp = 0; sp < 17; ++sp) { const int it = chain * 17 + sp; cj[sp] = cst[(size_t)it * 129 * 128 + el]; mj[sp] = sc[it * 32]; gj[sp] = sc[it * 32 + 1]; }
    float mst = 0.f, val = 0.f;
#pragma unroll
    for (int sp = 0; sp < 17; ++sp) {
      const int it = chain * 17 + sp;
      cst[(size_t)it * 129 * 128 + el] = val; if (el == 0) mprev[it * 32] = mst;
      const float mnew = fmaxf(gj[sp] + mst, mj[sp]);
      val = __expf(gj[sp] + mst - mnew) * val + __expf(mj[sp] - mnew) * cj[sp]; mst = mnew;
    }
  }
}
__device__ __forceinline__ void ml_out_item(CPR p, LAS unsigned char* lds, int l, int it, int half) {
  const MlItem m = ml_decode(it);
  const bf16_t* P = (const bf16_t*)(p.ws + O_P); const bf16_t* qb = (const bf16_t*)(p.ws + O_Q); const bf16_t* kb = (const bf16_t*)(p.ws + O_K);
  bf16_t* hd = (bf16_t*)(p.ws + O_HDIR) + (size_t)m.dir * MT * 512;
  LAS bf16_t* Qs = (LAS bf16_t*)lds;
  LAS bf16_t* Ks = Qs + 64 * 136;
  LAS bf16_t* VT = Ks + 64 * 136;
  LAS bf16_t* Ss = VT + 144 * 72;
  LAS bf16_t* CP = Ss + 64 * 72;
  LAS float* bcsA = (LAS float*)(CP + 144 * 136); LAS float* colvA = bcsA + 256; LAS float* pmaxA = colvA + 256; LAS float* MA = pmaxA + 256; LAS float* nqs = MA + 256; LAS float* tmp = nqs + 64;
  const int tid = ltid(), wid = tid >> 6, lane = tid & 63, cl = lane & 15, quad = lane >> 4;
  __syncthreads();
  ml_gate_scan(p, l, m, bcsA, colvA, pmaxA, tmp);
  const float mprev = ((const float*)(p.ws + O_SC + SM(l)))[(544 + it) * 32];
  if (tid < 256) MA[tid] = fmaxf(pmaxA[tid], mprev);
  {
    const float* cst = (const float*)(p.ws + O_CST) + (size_t)it * 129 * 128;
    for (int i = tid; i < 144 * 32; i += NTHR) { const int d = i >> 5, e4 = (i & 31) * 4; u32x2 o; o.x = 0; o.y = 0;
      if (d < 129) { const float4 v = *(const float4*)(cst + (size_t)d * 128 + e4); o.x = cvt_pk_bf16(v.x, v.y); o.y = cvt_pk_bf16(v.z, v.w); }
      *(LAS u32x2*)(CP + d * 136 + e4) = o; }
  }
  const int rt = wid >> 1; const int ct0 = (wid & 1) ? 5 : 0; const int nct = (wid & 1) ? 4 : 5;
#pragma unroll 1
  for (int qi = 0; qi < 2; ++qi) {
    const int qt = half ? 1 + qi : 3 * qi;
    __syncthreads();
    for (int i = tid; i < 64 * 16; i += NTHR) { const int r = i >> 4, c8 = (i & 15) * 8; const int tau = 64 * qt + r; const int row = m.rb + (m.dir ? 255 - tau : tau);
      *(LAS u32x4*)(Qs + r * 136 + c8) = *(const u32x4*)(qb + (size_t)row * 512 + m.h * 128 + c8); }
    u32x4 kreg[2]; bf16x8 vreg[2];
#pragma unroll
    for (int u = 0; u < 2; ++u) { const int i = tid + u * NTHR; const int r = i >> 4, c8 = (i & 15) * 8; const int row = m.rb + (m.dir ? 255 - r : r);
      const int rv = i & 63, cv = (i >> 6) * 8; const int rowv = m.rb + (m.dir ? 255 - rv : rv);
      kreg[u] = *(const u32x4*)(kb + (size_t)row * 512 + m.h * 128 + c8); vreg[u] = *(const bf16x8*)(P + (size_t)rowv * PW + 1536 + m.h * 128 + cv); }
    f32x4 acc[5];
#pragma unroll
    for (int t = 0; t < 5; ++t) acc[t] = (f32x4){0.f, 0.f, 0.f, 0.f};
#pragma unroll 1
    for (int kt = 0; kt <= qt; ++kt) {
      __syncthreads();
#pragma unroll
      for (int u = 0; u < 2; ++u) { const int i = tid + u * NTHR; const int r = i >> 4, c8 = (i & 15) * 8; const int rv = i & 63, cv = (i >> 6) * 8;
        *(LAS u32x4*)(Ks + r * 136 + c8) = kreg[u];
#pragma unroll
        for (int j = 0; j < 8; ++j) VT[(cv + j) * 72 + rv] = (bf16_t)vreg[u][j]; }
      if (kt < qt) {
#pragma unroll
        for (int u = 0; u < 2; ++u) { const int i = tid + u * NTHR; const int r = i >> 4, c8 = (i & 15) * 8; const int sg = 64 * (kt + 1) + r; const int row = m.rb + (m.dir ? 255 - sg : sg);
          const int rv = i & 63, cv = (i >> 6) * 8; const int sgv = 64 * (kt + 1) + rv; const int rowv = m.rb + (m.dir ? 255 - sgv : sgv);
          kreg[u] = *(const u32x4*)(kb + (size_t)row * 512 + m.h * 128 + c8); vreg[u] = *(const bf16x8*)(P + (size_t)rowv * PW + 1536 + m.h * 128 + cv); }
      }
      for (int i = tid; i < 16 * 64; i += NTHR) { const int d = 128 + (i >> 6), r = i & 63; VT[d * 72 + r] = (d == 128) ? (bf16_t)0x3f80 : (bf16_t)0; }
      __syncthreads();
#pragma unroll
      for (int c2 = 0; c2 < 2; ++c2) {
        const int ct = (wid & 1) * 2 + c2;
        f32x4 s = {0.f, 0.f, 0.f, 0.f};
#pragma unroll
        for (int ks = 0; ks < 4; ++ks) { const bf16x8 a = *(LAS const bf16x8*)(Qs + (16 * rt + cl) * 136 + 32 * ks + 8 * quad); const bf16x8 b = *(LAS const bf16x8*)(Ks + (16 * ct + cl) * 136 + 32 * ks + 8 * quad); s = MFMA16(a, b, s); }
        const int sg = 64 * kt + 16 * ct + cl; const float cvs = colvA[sg];
#pragma unroll
        for (int i = 0; i < 4; ++i) { const int tl = 16 * rt + quad * 4 + i; const int tau = 64 * qt + tl;
          const float v = (sg <= tau) ? s[i] * __expf(cvs - MA[tau]) : 0.f;
          Ss[tl * 72 + 16 * ct + cl] = f2bf(v); }
      }
      __syncthreads();
#pragma unroll
      for (int ks = 0; ks < 2; ++ks) {
        const bf16x8 a = *(LAS const bf16x8*)(Ss + (16 * rt + cl) * 72 + 32 * ks + 8 * quad);
#pragma unroll
        for (int t = 0; t < 5; ++t) { const int ctt = (ct0 + t) < 8 ? (ct0 + t) : 8;
          const bf16x8 b = *(LAS const bf16x8*)(VT + (16 * ctt + cl) * 72 + 32 * ks + 8 * quad); acc[t] = MFMA16(a, b, acc[t]); }
      }
    }
    {
      f32x4 ta[5];
#pragma unroll
      for (int t = 0; t < 5; ++t) ta[t] = (f32x4){0.f, 0.f, 0.f, 0.f};
#pragma unroll
      for (int ks = 0; ks < 4; ++ks) {
        const bf16x8 a = *(LAS const bf16x8*)(Qs + (16 * rt + cl) * 136 + 32 * ks + 8 * quad);
#pragma unroll
        for (int t = 0; t < 5; ++t) { const int ctt = (ct0 + t) < 8 ? (ct0 + t) : 8;
          const bf16x8 b = *(LAS const bf16x8*)(CP + (16 * ctt + cl) * 136 + 32 * ks + 8 * quad); ta[t] = MFMA16(a, b, ta[t]); }
      }
#pragma unroll
      for (int i = 0; i < 4; ++i) { const int tau = 64 * qt + 16 * rt + quad * 4 + i; const float wi = __expf(mprev - MA[tau]);
#pragma unroll
        for (int t = 0; t < 5; ++t) acc[t][i] += wi * ta[t][i]; }
    }
    if ((wid & 1) && cl == 0) {
#pragma unroll
      for (int i = 0; i < 4; ++i) nqs[16 * rt + quad * 4 + i] = acc[3][i];
    }
    __syncthreads();
#pragma unroll
    for (int i = 0; i < 4; ++i) {
      const int tl = 16 * rt + quad * 4 + i; const int tau = 64 * qt + tl; const int row = m.rb + (m.dir ? 255 - tau : tau);
      const float den = 1.f / fmaxf(fabsf(nqs[tl]), __expf(-(bcsA[tau] + MA[tau])));
#pragma unroll
      for (int t = 0; t < 5; ++t) { const int ct = ct0 + t; if (t < nct && ct < 8) hd[(size_t)row * 512 + m.h * 128 + 16 * ct + cl] = f2bf(acc[t][i] * den); }
    }
  }
}

__device__ __forceinline__ void ml_combine_row(CPR p, int l, int row) {
  const int lane = ltid() & 63; const int c8 = lane * 8;
  const bf16_t* P = (const bf16_t*)(p.ws + O_P); const bf16_t* hd = (const bf16_t*)(p.ws + O_HDIR); const bf16_t* xcb = (const bf16_t*)(p.ws + O_XC);
  bf16_t* ymix = (bf16_t*)(p.ws + O_ABUF);
  const bf16x8 hf = *(const bf16x8*)(hd + (size_t)row * 512 + c8), hb = *(const bf16x8*)(hd + ((size_t)MT + row) * 512 + c8);
  const bf16x8 xo = *(const bf16x8*)(P + (size_t)row * PW + 2048 + c8), xc = *(const bf16x8*)(xcb + (size_t)row * 512 + c8);
  float h[8]; float ss = 0.f;
#pragma unroll
  for (int j = 0; j < 8; ++j) { h[j] = bf2f((bf16_t)hf[j]) + bf2f((bf16_t)hb[j]); ss += h[j] * h[j]; }
#pragma unroll
  for (int o = 1; o < 16; o <<= 1) ss += __shfl_xor(ss, o);
  const float r = rsqrtf(ss * (1.f / 128.f) + EPS);
  const float* gain = p.in[36] + (size_t)l * 512 + c8; const float* skip = p.in[35] + (size_t)l * 512 + c8;
  float o[8];
#pragma unroll
  for (int j = 0; j < 8; ++j) o[j] = sigmoidf_(bf2f((bf16_t)xo[j])) * (h[j] * r * gain[j] + skip[j] * bf2f((bf16_t)xc[j]));
  u32x4 ov; ov.x = cvt_pk_bf16(o[0], o[1]); ov.y = cvt_pk_bf16(o[2], o[3]); ov.z = cvt_pk_bf16(o[4], o[5]); ov.w = cvt_pk_bf16(o[6], o[7]);
  *(u32x4*)(ymix + (size_t)row * 1024 + 512 + c8) = ov;
}

__device__ __forceinline__ void s5_glu_item(CPR p, LAS unsigned char* lds, int l, int it) {
  const bf16_t* P = (const bf16_t*)(p.ws + O_P); const float* Yd = (const float*)(p.ws + O_YDIR); bf16_t* ymix = (bf16_t*)(p.ws + O_ABUF);
  const bf16_t* wg = (const bf16_t*)(p.ws + O_WGLUT + SM(l));
  LAS bf16_t* G = (LAS bf16_t*)lds;
  const int tid = ltid(), wid = tid >> 6, lane = tid & 63, cl = lane & 15, quad = lane >> 4;
  __syncthreads();
  for (int i = tid; i < 64 * 64; i += NTHR) {
    const int r = i >> 6, c4 = (i & 63) * 4; const size_t row = (size_t)it * 64 + r;
    const int gg = c4 >> 4, cc = c4 & 15;
    const float4 yf = *(const float4*)(Yd + ((size_t)gg * MT + row) * 16 + cc), yb = *(const float4*)(Yd + ((size_t)(16 + gg) * MT + row) * 16 + cc);
    const u32x2 uv = *(const u32x2*)(P + row * PW + 768 + c4);
    const float4 dd = *(const float4*)(p.in[28] + (size_t)l * 256 + c4);
    float y[4] = {yf.x + yb.x + dd.x * __uint_as_float(uv.x << 16), yf.y + yb.y + dd.y * __uint_as_float(uv.x & 0xffff0000u),
                  yf.z + yb.z + dd.z * __uint_as_float(uv.y << 16), yf.w + yb.w + dd.w * __uint_as_float(uv.y & 0xffff0000u)};
#pragma unroll
    for (int j = 0; j < 4; ++j) { const float x = y[j]; y[j] = 0.5f * x * (1.f + tanhf(0.7978845608028654f * (x + 0.044715f * x * x * x))); }
    u32x2 o; o.x = cvt_pk_bf16(y[0], y[1]); o.y = cvt_pk_bf16(y[2], y[3]);
    *(LAS u32x2*)(G + r * 264 + c4) = o;
  }
  __syncthreads();
  f32x4 acc[2][4];
#pragma unroll
  for (int a = 0; a < 2; ++a)
#pragma unroll
    for (int b = 0; b < 4; ++b) acc[a][b] = (f32x4){0.f, 0.f, 0.f, 0.f};
#pragma unroll 2
  for (int kk = 0; kk < 8; ++kk) {
    bf16x8 bf[2], af[4];
#pragma unroll
    for (int c2 = 0; c2 < 2; ++c2) bf[c2] = *(const bf16x8*)(wg + (size_t)(16 * (2 * wid + c2) + cl) * 256 + 32 * kk + 8 * quad);
#pragma unroll
    for (int r4 = 0; r4 < 4; ++r4) af[r4] = *(LAS const bf16x8*)(G + (16 * r4 + cl) * 264 + 32 * kk + 8 * quad);
#pragma unroll
    for (int c2 = 0; c2 < 2; ++c2)
#pragma unroll
      for (int r4 = 0; r4 < 4; ++r4) acc[c2][r4] = MFMA16(af[r4], bf[c2], acc[c2][r4]);
  }
#pragma unroll
  for (int c2 = 0; c2 < 2; ++c2) {
    const int n = 16 * (2 * wid + c2) + cl; const float bg = p.in[30][(size_t)l * 256 + n];
#pragma unroll
    for (int r4 = 0; r4 < 4; ++r4)
#pragma unroll
      for (int i = 0; i < 4; ++i) { const int r = 16 * r4 + quad * 4 + i; const float g = bf2f(G[r * 264 + n]);
        ymix[((size_t)it * 64 + r) * 1024 + 256 + n] = f2bf(g * sigmoidf_(acc[c2][r4][i] + bg)); }
  }
}
#define XB_TMO      128
#define XB_XCNT(j)  (256  + 64 * (j))
#define XB_XSUB(j)  (1280 + 64 * (j))
#define XB_XGEN(j)  (2304 + 64 * (j))
#define XB_TOP      3328
#define XB_TOPGEN   3392
#define XCD_BAR_WORDS 3456
#define XB_SPIN_CAP (1u << 18)

__device__ __forceinline__ unsigned xb_ld(unsigned* p)              { return __hip_atomic_load(p, __ATOMIC_RELAXED, __HIP_MEMORY_SCOPE_AGENT); }
__device__ __forceinline__ unsigned xb_add(unsigned* p, unsigned v) { return __hip_atomic_fetch_add(p, v, __ATOMIC_RELAXED, __HIP_MEMORY_SCOPE_AGENT); }
__device__ __forceinline__ unsigned xb_xcc_id() { return (unsigned)__builtin_amdgcn_s_getreg((3 << 11) | 20) & 0xFu; }
#define XB_SPIN(cond, bar) do { unsigned _sp = 0; while (cond) { __builtin_amdgcn_s_sleep(1); \
    if ((++_sp & 255u) == 0u) { if (xb_ld(&(bar)[XB_TMO])) break; if (_sp > XB_SPIN_CAP) { atomicAdd(&(bar)[XB_TMO], 1u); break; } } } } while (0)

struct XcdBarrier {
    unsigned* bar; unsigned x;
    volatile LAS unsigned* st;
};

__device__ __forceinline__ XcdBarrier xcd_barrier_post(unsigned* bar, volatile LAS unsigned* st) {
    XcdBarrier b; b.bar = bar; b.x = xb_xcc_id(); b.st = st;
    if (threadIdx.x == 0) (void)xb_add(&bar[XB_XCNT(b.x)], 1u);
    return b;
}
__device__ __forceinline__ void xcd_barrier_complete(unsigned* bar, unsigned x, unsigned& nloc, unsigned& nx) {
    const unsigned G = gridDim.x * gridDim.y * gridDim.z;
    unsigned sum, cnt, mine, sp = 0u;
    for (;;) {
        sum = 0u; cnt = 0u; mine = 0u;
#pragma unroll
        for (unsigned j = 0; j < 16; ++j) { const unsigned c = xb_ld(&bar[XB_XCNT(j)]); sum += c; cnt += (c > 0u) ? 1u : 0u; mine = (j == x) ? c : mine; }
        if (sum == G) break;
        __builtin_amdgcn_s_sleep(1);
        if ((++sp & 255u) == 0u) { if (xb_ld(&bar[XB_TMO])) break; if (sp > XB_SPIN_CAP) { atomicAdd(&bar[XB_TMO], 1u); break; } }
    }
    nloc = mine > 0u ? mine : 1u; nx = cnt > 0u ? cnt : 1u;
}

__device__ __forceinline__ void xcd_barrier(const XcdBarrier& b) {
    asm volatile("s_waitcnt vmcnt(0)" ::: "memory");
    __syncthreads();
    if (threadIdx.x == 0) {
        unsigned* bar = b.bar;
        __builtin_amdgcn_s_waitcnt(0);
        unsigned nloc = b.st[0], nx = b.st[1];
        if (nloc == 0u) { xcd_barrier_complete(bar, b.x, nloc, nx); b.st[0] = nloc; b.st[1] = nx; }
        const unsigned old = xb_add(&bar[XB_XSUB(b.x)], 1u);
        const unsigned gen = old / nloc;
        if (old + 1u == (gen + 1u) * nloc) {
            __builtin_amdgcn_fence(__ATOMIC_RELEASE, "agent");
            asm volatile("s_waitcnt vmcnt(0)" ::: "memory");
            const unsigned og = xb_add(&bar[XB_TOP], 1u);
            const unsigned tg = og / nx;
            if (og + 1u == (tg + 1u) * nx) xb_add(&bar[XB_TOPGEN], 1u);
            else XB_SPIN(xb_ld(&bar[XB_TOPGEN]) == tg, bar);
            __builtin_amdgcn_fence(__ATOMIC_ACQUIRE, "agent");
            xb_add(&bar[XB_XGEN(b.x)], 1u);
            asm volatile("s_waitcnt vmcnt(0)" ::: "memory");
        } else {
            XB_SPIN(xb_ld(&bar[XB_XGEN(b.x)]) == gen, bar);
            __builtin_amdgcn_fence(__ATOMIC_ACQUIRE, "agent");
            asm volatile("s_waitcnt vmcnt(0)" ::: "memory");
        }
    }
    __syncthreads();
}

#define GSYNC() xcd_barrier(xb)
#define RUN_ITEMS(N, CALL) do { for (int it = first_item(off, G); it < (N); it += G) { CALL; } off = (off + (N)) % G; } while (0)

__global__ void __launch_bounds__(NTHR, 2) fwd_megakernel(Params p_arg) {
  CPR p = *(const __attribute__((address_space(4))) Params*)__builtin_amdgcn_kernarg_segment_ptr();
  extern __shared__ __attribute__((aligned(16))) unsigned char lds_raw[];
  LAS unsigned char* lds = (LAS unsigned char*)lds_raw;
  cg::grid_group grid = cg::this_grid();
  const int G = gridDim.x;
  const int wid = ltid() >> 6;
  unsigned char* ws = p.ws;
  float* modt = (float*)(ws + O_MOD);
  float* ctxcur = (float*)(ws + O_CTX);
  float* Ybuf = (float*)(ws + O_P);
  bf16_t* ABUF = (bf16_t*)(ws + O_ABUF);

  volatile LAS unsigned* xbst = (volatile LAS unsigned*)(lds + LDS_BYTES - 16);
  if (ltid() == 0) { xbst[0] = 0u; xbst[1] = 0u; xbst[2] = 0u; xbst[3] = 0u; }
  __syncthreads();
  const XcdBarrier xb = xcd_barrier_post((unsigned*)ws, xbst);
#ifndef PH_MASK
#define PH_MASK 0xffffffff
#endif
#define PH(n) if (PH_MASK & (1u << (n)))
  PH(0) phase_mod(p, lds);
  if (p_arg.ws == nullptr) grid.sync();
  GSYNC();

#pragma unroll 1
  for (int l = 0; l < DEPTH; ++l) {
    int off = 0;
    const int Mg = (l < DEPTH - 1) ? MT : MLAT;
    {
      RowCfg rc;
      rc.srcL = l == 0 ? p.in[0] : p.out; rc.srcC = l == 0 ? p.in[2] : ctxcur; rc.dstL = p.out; rc.dstC = ctxcur;
      rc.Y = l > 0 ? Ybuf : nullptr; rc.ypart = l > 0 ? Ybuf + (size_t)MT * 1024 : nullptr; rc.gpost = p.in[9] + (size_t)(l > 0 ? l - 1 : 0) * 1024; rc.modA = modt + (size_t)(l > 0 ? l - 1 : 0) * 5 * 6144; rc.gate_off = 5120;
      rc.gpre = p.in[6] + (size_t)l * 1024; rc.modB = modt + (size_t)l * 5 * 6144; rc.sc_off = 1024; rc.sh_off = 0; rc.abuf = ABUF;
      PH(1) RUN_ITEMS(NCONV, conv_item(p, lds, l, it));
      PH(2) RUN_ITEMS(272, hyfilt_item(p, lds, l, it));
      PH(3) RUN_ITEMS(4, s5tab_item(p, l, it));
      PH(4) for (int W = (int)blockIdx.x * 8 + wid; W < MLAT / 8; W += G * 8) row_block(rc, W, true);
    }
    GSYNC();
    {
      pg8::Gemm g{ABUF, (const bf16_t*)(ws + O_WINT), MT, PWP, 1024, 1024};
      pg8::StaticOrder S; S.init(g.M, g.N, G, blockIdx.x);
      pg8::EpiP E{(bf16_t*)(ws + O_P), (float*)(ws + O_PG)};
      PH(5) pg8::gemm_phase(lds, g, S, E);
    }
    GSYNC();
    off = 0;
    PH(6) RUN_ITEMS(1088, mlqk_item(p, lds, l, it));
    __syncthreads();
    PH(7) RUN_ITEMS(1088, { __syncthreads(); s5_chunk<true>(p, lds + wid * 12800, it * 8 + wid, l, true); });
    PH(8) RUN_ITEMS(816, hyshort_item(p, lds, l, it));
    GSYNC();
    off = 0;
    PH(9) RUN_ITEMS(256, { hyena_seq(p, lds, l, it, 0); if (l < DEPTH - 1) hyena_seq(p, lds, l, it, 1); });
    PH(10) RUN_ITEMS(544, ml_cloc_item(p, lds, l, it));
    PH(11) RUN_ITEMS(16, s5_carry_item(p, it, l));
    GSYNC();
    off = 0;
    PH(12) ml_carry(p, l);
    PH(13) RUN_ITEMS(1088, { __syncthreads(); s5_chunk<true>(p, lds + wid * 12800, it * 8 + wid, l, false); });
    PH(14) RUN_ITEMS(Mg / 64, hytrans_item(p, lds, it));
    GSYNC();
    off = 0;
    PH(15) RUN_ITEMS(l < DEPTH - 1 ? 1088 : 1024, ml_out_item(p, lds, l, l < DEPTH - 1 ? (it >> 1) : ((it >> 5) * 17 + 1 + ((it >> 1) & 15)), it & 1));
    PH(16) RUN_ITEMS(Mg / 64, s5_glu_item(p, lds, l, it));
    GSYNC();
    off = 0;
    PH(17) RUN_ITEMS(Mg / 8, ml_combine_row(p, l, it * 8 + wid));
#ifdef DBG_ZERO
    { bf16_t* ym = (bf16_t*)(ws + O_ABUF);
      for (int i = blockIdx.x * NTHR + ltid(); i < MT * 128; i += G * NTHR) { const int row = i >> 7, c8 = (i & 127) * 8; const u32x4 z = {0u, 0u, 0u, 0u};
        if (c8 >= 512 ? !(PH_MASK & (1u << 17)) : (c8 >= 256 ? !(PH_MASK & (1u << 16)) : !(PH_MASK & (1u << 14)))) *(u32x4*)(ym + (size_t)row * 1024 + c8) = z; } }
#endif
    GSYNC();
    {
      pg8::Gemm g{ABUF, (const bf16_t*)(ws + O_WOUTT), MLAT, 1024, 1024, 1024};
      pg8::StaticOrder S; S.init(g.M, g.N, G, blockIdx.x);
      pg8::EpiF32 E{Ybuf};
      PH(18) pg8::gemm_phase(lds, g, S, E);
      if (l < DEPTH - 1) {
        pg8::Gemm g2{ABUF, (const bf16_t*)(ws + O_WOUTT), MT, 1024, 256, 1024};
        pg8::CtxSplitOrder S2; S2.init(G, blockIdx.x);
        pg8::EpiF32Split E2{Ybuf, Ybuf + (size_t)MT * 1024};
        PH(18) pg8::gemm_phase(lds, g2, S2, E2);
      }
    }
    GSYNC();
    {
      RowCfg rc;
      rc.srcL = p.out; rc.srcC = ctxcur; rc.dstL = p.out; rc.dstC = ctxcur;
      rc.Y = Ybuf; rc.ypart = (l < DEPTH - 1) ? Ybuf + (size_t)MT * 1024 : nullptr; rc.gpost = p.in[7] + (size_t)l * 1024; rc.modA = modt + (size_t)l * 5 * 6144; rc.gate_off = 2048;
      rc.gpre = p.in[8] + (size_t)l * 1024; rc.modB = rc.modA; rc.sc_off = 4096; rc.sh_off = 3072; rc.abuf = ABUF;
      off = 0;
      PH(19) for (int W = (int)blockIdx.x * 8 + wid; W < MLAT / 8; W += G * 8) row_block(rc, W, l < DEPTH - 1);
    }
    GSYNC();
    {
      pg8::Gemm g{ABUF, (const bf16_t*)(ws + O_W1T), Mg, 4096, 1024, 1024};
      pg8::StaticOrder S; S.init(g.M, g.N, G, blockIdx.x);
      pg8::EpiRelu2 E{(bf16_t*)(ws + O_MIX)};
      PH(20) pg8::gemm_phase(lds, g, S, E);
    }
    GSYNC();
    {
      pg8::Gemm g{(const bf16_t*)(ws + O_MIX), (const bf16_t*)(ws + O_W2T), MLAT, 1024, 4096, 4096};
      pg8::StaticOrder S; S.init(g.M, g.N, G, blockIdx.x);
      pg8::EpiF32 E{Ybuf};
      PH(21) pg8::gemm_phase(lds, g, S, E);
      if (l < DEPTH - 1) {
        pg8::Gemm g2{(const bf16_t*)(ws + O_MIX), (const bf16_t*)(ws + O_W2T), MT, 1024, 1024, 4096};
        pg8::CtxSplitOrder S2; S2.init(G, blockIdx.x);
        pg8::EpiF32Split E2{Ybuf, Ybuf + (size_t)MT * 1024};
        PH(21) pg8::gemm_phase(lds, g2, S2, E2);
      }
    }
    GSYNC();
  }
  {
    RowCfg rc;
    rc.srcL = p.out; rc.srcC = ctxcur; rc.dstL = p.out; rc.dstC = ctxcur;
    rc.Y = Ybuf; rc.ypart = nullptr; rc.gpost = p.in[9] + (size_t)(DEPTH - 1) * 1024; rc.modA = modt + (size_t)(DEPTH - 1) * 5 * 6144; rc.gate_off = 5120;
    rc.gpre = nullptr; rc.modB = rc.modA; rc.sc_off = 0; rc.sh_off = 0; rc.abuf = ABUF;
    int off = 0;
    PH(22) for (int W = (int)blockIdx.x * 8 + wid; W < MLAT / 8; W += G * 8) row_block(rc, W, false);
  }
}

extern "C" void kernel_launch(void* const* d_in, const int* in_sizes, int n_in, void* d_out, int out_size, void* d_ws, size_t ws_size, hipStream_t stream) {
  static int grid_blocks = 0;
  if (grid_blocks == 0) {
    if (n_in != 39 || ws_size < WS_NEED) { fprintf(stderr, "kernel_launch: need 39 inputs and %zu bytes of workspace; got %d, %zu\n", (size_t)WS_NEED, n_in, ws_size); grid_blocks = -1; return; }
    int dev = 0, cus = 0, per_cu = 0;
    hipGetDevice(&dev);
    hipDeviceGetAttribute(&cus, hipDeviceAttributeMultiprocessorCount, dev);
    if (hipFuncSetAttribute((const void*)fwd_megakernel, hipFuncAttributeMaxDynamicSharedMemorySize, LDS_BYTES) != hipSuccess) { fprintf(stderr, "kernel_launch: hipFuncSetAttribute failed\n"); grid_blocks = -1; return; }
    if (hipOccupancyMaxActiveBlocksPerMultiprocessor(&per_cu, (const void*)fwd_megakernel, NTHR, LDS_BYTES) != hipSuccess || per_cu < 1) { fprintf(stderr, "kernel_launch: occupancy query gave %d\n", per_cu); per_cu = 1; }
    (void)hipGetLastError();
    grid_blocks = cus;
  }
  if (grid_blocks < 0) return;
  if (hipMemsetAsync(d_ws, 0, XCD_BAR_WORDS * sizeof(unsigned), stream) != hipSuccess) { fprintf(stderr, "kernel_launch: memset of the barrier words failed\n"); return; }
  Params p{};
  for (int i = 0; i < 39; ++i) p.in[i] = (const float*)d_in[i];
  p.out = (float*)d_out; p.ws = (unsigned char*)d_ws;
  void* args[] = {&p};
  hipError_t e = hipLaunchCooperativeKernel((const void*)fwd_megakernel, dim3(grid_blocks), dim3(NTHR), args, LDS_BYTES, stream);
  if (e != hipSuccess) fprintf(stderr, "cooperative launch failed: %s (grid %d)\n", hipGetErrorString(e), grid_blocks);
}
```
